# Optimizing an MI355X kernel written in HIP

```python
import math
import jax, jax.numpy as jnp
from jax import lax
import numpy as np

D_MODEL = 1024
BATCH = 4
SEQ = 8192
DEPTH = 2

D_MIX = D_MODEL
GLA_WIDTH = 3 * D_MIX // 8
GLA_HEADS = 6
GLA_DV = GLA_WIDTH // GLA_HEADS
GLA_DK = GLA_DV // 2
GLA_LOWRANK = 16
GLA_TAU = 16.0
HG_WIDTH = 3 * D_MIX // 8
HG_HEADS = 6
HG_DV = HG_WIDTH // HG_HEADS
HG_EXPAND = 64
HY_WIDTH = D_MIX - GLA_WIDTH - HG_WIDTH
HY_ORDER = 2
HY_SHORT = 3
HY_EMB = 33
HY_BANDS = (HY_EMB - 1) // 2
HY_FFN = 64
HY_INNER = 2
HY_FAST_DECAY = 0.3
HY_SLOW_DECAY = 1.5
HY_TARGET = 1e-2
CHUNK = 64
N_GROUPS = 4
EXPERTS_PER_GROUP = 4
N_EXPERTS = N_GROUPS * EXPERTS_PER_GROUP
TOP_K = 2
D_EXPERT = D_MODEL // 2
MOE_BLOCK = 256
ALPHA = (2 * DEPTH) ** 0.25
BETA = (8 * DEPTH) ** -0.25
LN_EPS = 1e-5
RMS_EPS = 1e-6
LB_FLOOR = 1e-30
IN_SPLITS = (GLA_HEADS * GLA_DK, GLA_HEADS * GLA_DK, GLA_WIDTH, GLA_WIDTH, 2 * GLA_LOWRANK,
             HG_HEADS * HG_EXPAND, 2 * HG_HEADS * HG_EXPAND, HG_WIDTH, HG_WIDTH, 3 * HY_WIDTH)
D_IN = sum(IN_SPLITS)

kernel_name = 'hybrid_gla_hgrn2_hyena_hmoe_deepnorm'


def layer_norm(x, g, b):
    xf = x.astype(jnp.float32)
    xc = xf - jnp.mean(xf, axis=-1, keepdims=True)
    var = jnp.mean(xc * xc, axis=-1, keepdims=True)
    return (xc * lax.rsqrt(var + LN_EPS) * g.astype(jnp.float32) + b.astype(jnp.float32)).astype(x.dtype)


def head_rms_norm(o, g):
    of = o.astype(jnp.float32)
    of = of * lax.rsqrt(jnp.mean(of * of, axis=-1, keepdims=True) + RMS_EPS)
    return (of.reshape(o.shape[0], o.shape[1], -1) * g.astype(jnp.float32)).astype(o.dtype)


def chunked_gated_scan(q, k, v, log_g):
    out_dtype = v.dtype
    B, L, H, K = q.shape
    V = v.shape[-1]
    N = L // CHUNK

    def to_chunks(a):
        return a.astype(jnp.float32).reshape(B, N, CHUNK, H, a.shape[-1]).transpose(1, 0, 3, 2, 4)

    qc, kc, vc, gc = to_chunks(q), to_chunks(k), to_chunks(v), to_chunks(log_g)
    gc = jnp.cumsum(gc, axis=3)
    lower = jnp.tril(jnp.ones((CHUNK, CHUNK), dtype=bool))[:, :, None]

    def step(state, blk):
        qb, kb, vb, gb = blk
        g_end = gb[:, :, -1:, :]
        inter = jnp.einsum('bhik,bhkv->bhiv', qb * jnp.exp(gb), state)
        diff = gb[:, :, :, None, :] - gb[:, :, None, :, :]
        decay = jnp.where(lower, jnp.exp(jnp.where(lower, diff, 0.0)), 0.0)
        scores = jnp.einsum('bhik,bhjk,bhijk->bhij', qb, kb, decay)
        intra = jnp.einsum('bhij,bhjv->bhiv', scores, vb)
        state = (jnp.exp(g_end[:, :, 0, :])[..., None] * state
                 + jnp.einsum('bhjk,bhjv->bhkv', kb * jnp.exp(g_end - gb), vb))
        return state, inter + intra

    s0 = jnp.zeros((B, H, K, V), jnp.float32)
    _, out = lax.scan(step, s0, (qc, kc, vc, gc))
    return out.transpose(1, 0, 3, 2, 4).reshape(B, L, H, V).astype(out_dtype)


def bidirectional_scan(q, k_fwd, k_bwd, v, g_fwd, g_bwd):
    rev = lambda a: jnp.flip(a, axis=1)
    fwd = chunked_gated_scan(q, k_fwd, v, g_fwd)
    bwd = rev(chunked_gated_scan(rev(q), rev(k_bwd), rev(v), rev(g_bwd)))
    return fwd + bwd


def hyena_filter_spectrum(L, w1, b1, freq, w2, b2, w3):
    f32 = jnp.float32
    t = jnp.linspace(0.0, 1.0, L, dtype=f32)[:, None]
    w = 2.0 * math.pi * jnp.arange(L, dtype=f32)[:, None] / L
    bands = jnp.linspace(1e-4, HY_BANDS - 1, HY_BANDS, dtype=f32)[None, :]
    z = jnp.concatenate([t, jnp.cos(bands * w), -jnp.sin(bands * w)], axis=-1)
    fr = freq.astype(f32)
    h = jnp.sin(fr * (z @ w1.astype(f32) + b1.astype(f32)))
    for i in range(HY_INNER):
        h = jnp.sin(fr * (h @ w2[i].astype(f32) + b2[i].astype(f32)))
    h = (h @ w3.astype(f32)).reshape(L, HY_ORDER, 2, HY_WIDTH)
    max_decay = math.log(HY_TARGET) / HY_FAST_DECAY
    min_decay = math.log(HY_TARGET) / HY_SLOW_DECAY
    deltas = jnp.linspace(min_decay, max_decay, HY_WIDTH, dtype=f32)
    h = h * jnp.exp(-t * jnp.abs(deltas))[:, None, None, :]
    k = jnp.concatenate([h[:, :, 0], jnp.zeros((1, HY_ORDER, HY_WIDTH), f32),
                         jnp.flip(h[1:, :, 1], axis=0)], axis=0)
    k = k / jnp.maximum(jnp.sum(jnp.abs(k), axis=0, keepdims=True), 1e-12)
    return jnp.fft.rfft(k, axis=0)


def hyena_mixer(u, conv_w, conv_b, k_spec, bias):
    out_dtype = u.dtype
    C = u.shape[-1]
    L = u.shape[1]
    pad = (HY_SHORT - 1) // 2
    u = lax.conv_general_dilated(u, conv_w[:, None, :], (1,), ((pad, pad),),
                                 dimension_numbers=('NWC', 'WIO', 'NWC'),
                                 feature_group_count=C) + conv_b
    v, x1, x2 = jnp.split(u.astype(jnp.float32), 3, axis=-1)
    z = v
    for o, gate in enumerate((x1, x2)):
        zf = jnp.fft.rfft(z, n=2 * L, axis=1)
        conv = jnp.fft.irfft(zf * k_spec[:, o][None], n=2 * L, axis=1)[:, :L]
        z = gate * (conv + z * bias[o].astype(jnp.float32))
    return z.astype(out_dtype)


def hybrid_token_mixer(h, w_in, gla_wa2, gla_ba, gla_norm_g, lb, hg_norm_g,
                       hy_conv_w, hy_conv_b, hy_spec, hy_bias, w_out):
    B, L, _ = h.shape
    proj = h @ w_in
    cuts = np.cumsum(IN_SPLITS)[:-1].tolist()
    gq, gk, gv, gg, ga, hq, hf, hi, hgt, hyu = jnp.split(proj, cuts, axis=-1)

    q = gq.reshape(B, L, GLA_HEADS, GLA_DK) * (GLA_DK ** -0.5)
    k = gk.reshape(B, L, GLA_HEADS, GLA_DK)
    v = gv.reshape(B, L, GLA_HEADS, GLA_DV)
    a_logit = jnp.einsum('bldr,drk->bldk', ga.reshape(B, L, 2, GLA_LOWRANK), gla_wa2) + gla_ba
    log_a = (jax.nn.log_sigmoid(a_logit.astype(jnp.float32)) / GLA_TAU).reshape(B, L, 2, GLA_HEADS, GLA_DK)
    o_gla = bidirectional_scan(q, k, k, v, log_a[:, :, 0], log_a[:, :, 1])
    y_gla = head_rms_norm(o_gla, gla_norm_g) * jax.nn.silu(gg)

    qh = jax.nn.silu(hq).reshape(B, L, HG_HEADS, HG_EXPAND)
    zf = hf.reshape(B, L, 2, HG_HEADS * HG_EXPAND).astype(jnp.float32)
    lbf = lb.astype(jnp.float32)
    log_f = jnp.logaddexp(jnp.log1p(-lbf) + jax.nn.log_sigmoid(zf),
                          jnp.log(jnp.maximum(lbf, LB_FLOOR)))
    one_minus_f = (1.0 - lbf) * jax.nn.sigmoid(-zf)
    log_f = log_f.reshape(B, L, 2, HG_HEADS, HG_EXPAND)
    one_minus_f = one_minus_f.reshape(B, L, 2, HG_HEADS, HG_EXPAND)
    vi = hi.reshape(B, L, HG_HEADS, HG_DV)
    o_hg = bidirectional_scan(qh, one_minus_f[:, :, 0], one_minus_f[:, :, 1], vi,
                              log_f[:, :, 0], log_f[:, :, 1])
    y_hg = head_rms_norm(o_hg, hg_norm_g) * jax.nn.sigmoid(hgt)

    y_hy = hyena_mixer(hyu, hy_conv_w, hy_conv_b, hy_spec, hy_bias)

    mix = jnp.concatenate([y_gla.astype(h.dtype), y_hg.astype(h.dtype), y_hy], axis=-1)
    return mix @ w_out


def hierarchical_moe(x, wr_g, br_g, wr_e, br_e, w_gate, w_up, w_down):
    B, L, D = x.shape
    T = B * L
    xt = x.reshape(T, D)
    pg = jax.nn.softmax((xt @ wr_g).astype(jnp.float32) + br_g.astype(jnp.float32), axis=-1)
    g_val, g_idx = lax.top_k(pg, 1)
    le = ((xt @ wr_e).astype(jnp.float32) + br_e.astype(jnp.float32)).reshape(T, N_GROUPS, EXPERTS_PER_GROUP)
    le = le[jnp.arange(T), g_idx[:, 0]]
    pe = jax.nn.softmax(le, axis=-1)
    e_val, e_idx = lax.top_k(pe, TOP_K)
    e_val = e_val / jnp.sum(e_val, axis=-1, keepdims=True)
    weights = g_val * e_val
    experts = g_idx * EXPERTS_PER_GROUP + e_idx

    A = T * TOP_K
    flat_e = experts.reshape(A)
    flat_w = weights.reshape(A)
    flat_t = jnp.repeat(jnp.arange(T, dtype=jnp.int32), TOP_K)
    order = jnp.argsort(flat_e)
    se, sw, st = flat_e[order], flat_w[order], flat_t[order]
    counts = jnp.bincount(flat_e, length=N_EXPERTS)
    padded = ((counts + MOE_BLOCK - 1) // MOE_BLOCK) * MOE_BLOCK
    start = jnp.cumsum(counts) - counts
    pend = jnp.cumsum(padded)
    pstart = pend - padded
    dest = pstart[se] + (jnp.arange(A) - start[se])
    NB = -(-A // MOE_BLOCK) + N_EXPERTS
    slot_tok = jnp.full((NB * MOE_BLOCK,), T, jnp.int32).at[dest].set(st)
    slot_w = jnp.zeros((NB * MOE_BLOCK,), jnp.float32).at[dest].set(sw)
    block_e = jnp.minimum(jnp.searchsorted(pend, jnp.arange(NB) * MOE_BLOCK, side='right'), N_EXPERTS - 1)
    x_pad = jnp.concatenate([xt, jnp.zeros((1, D), xt.dtype)], axis=0)

    def run_block(args):
        tok, e = args
        xb = x_pad[tok]
        hid = jax.nn.silu(xb @ w_gate[e]) * (xb @ w_up[e])
        return hid @ w_down[e]

    yb = lax.map(run_block, (slot_tok.reshape(NB, MOE_BLOCK), block_e))
    y = jax.ops.segment_sum(yb.reshape(NB * MOE_BLOCK, D).astype(jnp.float32) * slot_w[:, None],
                            slot_tok, num_segments=T + 1)[:T]
    return y.reshape(B, L, D).astype(x.dtype)


def setup_inputs(seed: int = 0) -> dict:
    key = jax.random.key(seed)
    ks = iter(jax.random.split(key, 32))
    f32 = jnp.float32

    def nrm(shape, scale):
        return jax.random.normal(next(ks), shape, f32) * scale

    x = nrm((BATCH, SEQ, D_MODEL), 1.0)
    ln_in_g = 1.0 + nrm((D_MODEL,), 0.02)
    ln_in_b = nrm((D_MODEL,), 0.02)
    col_scale = np.ones((D_IN,), np.float32)
    offs = np.concatenate([[0], np.cumsum(IN_SPLITS)])
    col_scale[offs[2]:offs[3]] = BETA
    col_scale[offs[7]:offs[8]] = BETA
    col_scale[offs[9]:offs[9] + HY_WIDTH] = BETA
    w_in = nrm((DEPTH, D_MODEL, D_IN), D_MODEL ** -0.5) * jnp.asarray(col_scale)
    gla_wa2 = nrm((DEPTH, 2, GLA_LOWRANK, GLA_HEADS * GLA_DK), GLA_LOWRANK ** -0.5)
    gla_ba = nrm((DEPTH, 2, GLA_HEADS * GLA_DK), 0.1)
    gla_norm_g = 1.0 + nrm((DEPTH, GLA_WIDTH), 0.02)
    hg_lb_logits = nrm((DEPTH, 2, HG_HEADS * HG_EXPAND), 0.1)
    hg_norm_g = 1.0 + nrm((DEPTH, HG_WIDTH), 0.02)
    hy_conv_w = nrm((DEPTH, HY_SHORT, 3 * HY_WIDTH), HY_SHORT ** -0.5)
    hy_conv_b = nrm((DEPTH, 3 * HY_WIDTH), 0.02)
    hy_w1 = nrm((DEPTH, HY_EMB, HY_FFN), HY_EMB ** -0.5)
    hy_b1 = nrm((DEPTH, HY_FFN), 0.02)
    hy_freq = 1.0 + nrm((DEPTH, HY_FFN), 0.1)
    hy_w2 = nrm((DEPTH, HY_INNER, HY_FFN, HY_FFN), HY_FFN ** -0.5)
    hy_b2 = nrm((DEPTH, HY_INNER, HY_FFN), 0.02)
    hy_w3 = nrm((DEPTH, HY_FFN, HY_ORDER * 2 * HY_WIDTH), HY_FFN ** -0.5)
    hy_bias = nrm((DEPTH, HY_ORDER, HY_WIDTH), 1.0)
    w_out = nrm((DEPTH, D_MIX, D_MODEL), D_MIX ** -0.5 * BETA)
    ln1_g = 1.0 + nrm((DEPTH, D_MODEL), 0.02)
    ln1_b = nrm((DEPTH, D_MODEL), 0.02)
    moe_wr_g = nrm((DEPTH, D_MODEL, N_GROUPS), D_MODEL ** -0.5)
    moe_br_g = nrm((DEPTH, N_GROUPS), 0.01)
    moe_wr_e = nrm((DEPTH, D_MODEL, N_EXPERTS), D_MODEL ** -0.5)
    moe_br_e = nrm((DEPTH, N_EXPERTS), 0.01)
    moe_w_gate = nrm((DEPTH, N_EXPERTS, D_MODEL, D_EXPERT), D_MODEL ** -0.5 * BETA)
    moe_w_up = nrm((DEPTH, N_EXPERTS, D_MODEL, D_EXPERT), D_MODEL ** -0.5 * BETA)
    moe_w_down = nrm((DEPTH, N_EXPERTS, D_EXPERT, D_MODEL), D_EXPERT ** -0.5 * BETA)
    ln2_g = 1.0 + nrm((DEPTH, D_MODEL), 0.02)
    ln2_b = nrm((DEPTH, D_MODEL), 0.02)
    return {'x': x, 'ln_in_g': ln_in_g, 'ln_in_b': ln_in_b, 'w_in': w_in,
            'gla_wa2': gla_wa2, 'gla_ba': gla_ba, 'gla_norm_g': gla_norm_g,
            'hg_lb_logits': hg_lb_logits, 'hg_norm_g': hg_norm_g,
            'hy_conv_w': hy_conv_w, 'hy_conv_b': hy_conv_b, 'hy_w1': hy_w1, 'hy_b1': hy_b1,
            'hy_freq': hy_freq, 'hy_w2': hy_w2, 'hy_b2': hy_b2, 'hy_w3': hy_w3, 'hy_bias': hy_bias,
            'w_out': w_out, 'ln1_g': ln1_g, 'ln1_b': ln1_b,
            'moe_wr_g': moe_wr_g, 'moe_br_g': moe_br_g, 'moe_wr_e': moe_wr_e, 'moe_br_e': moe_br_e,
            'moe_w_gate': moe_w_gate, 'moe_w_up': moe_w_up, 'moe_w_down': moe_w_down,
            'ln2_g': ln2_g, 'ln2_b': ln2_b}


def reference(x, ln_in_g, ln_in_b, w_in, gla_wa2, gla_ba, gla_norm_g, hg_lb_logits, hg_norm_g,
              hy_conv_w, hy_conv_b, hy_w1, hy_b1, hy_freq, hy_w2, hy_b2, hy_w3, hy_bias,
              w_out, ln1_g, ln1_b, moe_wr_g, moe_br_g, moe_wr_e, moe_br_e,
              moe_w_gate, moe_w_up, moe_w_down, ln2_g, ln2_b):
    L = x.shape[1]
    p = jax.nn.softmax(hg_lb_logits.astype(jnp.float32), axis=0)
    lower_bounds = jnp.cumsum(p, axis=0) - p[0:1]
    h = layer_norm(x, ln_in_g, ln_in_b)
    for l in range(DEPTH):
        hy_spec = hyena_filter_spectrum(L, hy_w1[l], hy_b1[l], hy_freq[l], hy_w2[l], hy_b2[l], hy_w3[l])
        mix = hybrid_token_mixer(h, w_in[l], gla_wa2[l], gla_ba[l], gla_norm_g[l], lower_bounds[l],
                                 hg_norm_g[l], hy_conv_w[l], hy_conv_b[l], hy_spec, hy_bias[l], w_out[l])
        h = layer_norm(ALPHA * h + mix, ln1_g[l], ln1_b[l])
        ffn = hierarchical_moe(h, moe_wr_g[l], moe_br_g[l], moe_wr_e[l], moe_br_e[l],
                               moe_w_gate[l], moe_w_up[l], moe_w_down[l])
        h = layer_norm(ALPHA * h + ffn, ln2_g[l], ln2_b[l])
    return h
```

```cpp
#ifndef CPU_EMU
#include <hip/hip_runtime.h>
#define LAUNCH(k, grid, block, stream, ...) hipLaunchKernelGGL(k, dim3(grid), dim3(block), 0, stream, __VA_ARGS__)
#endif
#include <cstdint>
#include <cstddef>

#ifndef SEQ_
#define SEQ_ 8192
#endif
#ifndef BATCH_
#define BATCH_ 4
#endif
constexpr int DM = 1024, NB = BATCH_, L = SEQ_, T = NB * L, DEPTH = 2, DIN = 3872;
constexpr int C_GQ = 0, C_GK = 192, C_GV = 384, C_GG = 768, C_GA = 1152, C_HQ = 1184, C_HF = 1568, C_HI = 2336, C_HGT = 2720, C_HY = 3104;
constexpr float ALPHA = 1.41421356237f, LN_EPS = 1e-5f, RMS_EPS = 1e-6f;

#ifdef CPU_EMU
typedef float pt;
__device__ __forceinline__ float ldp(const pt* p) { return *p; }
__device__ __forceinline__ void stp(pt* p, float v) { *p = v; }
#else
typedef unsigned short pt;
__device__ __forceinline__ float ldp(const pt* p) { return __uint_as_float(((unsigned)*p) << 16); }
__device__ __forceinline__ void stp(pt* p, float v) { unsigned u = __float_as_uint(v); *p = (pt)((u + 0x7fffu + ((u >> 16) & 1u)) >> 16); }
#endif

#ifdef CPU_EMU
#define FEXP(x) expf(x)
#define FDIV(a, b) ((a) / (b))
#else
#define FEXP(x) __expf(x)
#define FDIV(a, b) __fdividef(a, b)
#endif
__device__ __forceinline__ float sigmoidf_(float x) { return FDIV(1.0f, 1.0f + FEXP(-x)); }
__device__ __forceinline__ float siluf_(float x) { return FDIV(x, 1.0f + FEXP(-x)); }
__device__ __forceinline__ float logsigmoidf_(float x) { return fminf(x, 0.f) - log1pf(expf(-fabsf(x))); }

__global__ void k_ln(const float* a, const float* b, float alpha, const float* g, const float* be, float* out, int rows) {
    int r = blockIdx.x * blockDim.x + threadIdx.x; if (r >= rows) return;
    const float* ar = a + (size_t)r * DM; const float* br = b ? b + (size_t)r * DM : nullptr;
    float s = 0.f;
    for (int i = 0; i < DM; ++i) s += alpha * ar[i] + (br ? br[i] : 0.f);
    float mean = s / DM, q = 0.f;
    for (int i = 0; i < DM; ++i) { float d = alpha * ar[i] + (br ? br[i] : 0.f) - mean; q += d * d; }
    float rstd = 1.0f / sqrtf(q / DM + LN_EPS);
    float* o = out + (size_t)r * DM;
    for (int i = 0; i < DM; ++i) { float v = alpha * ar[i] + (br ? br[i] : 0.f); o[i] = (v - mean) * rstd * g[i] + be[i]; }
}

template <class TC> __device__ __forceinline__ void stc(TC* p, float v);
template <> __device__ __forceinline__ void stc<float>(float* p, float v) { *p = v; }
#ifndef CPU_EMU
template <> __device__ __forceinline__ void stc<pt>(pt* p, float v) { stp(p, v); }
#endif
template <class TC> __global__ void k_gemm(const float* A, int lda, const float* B, int ldb, TC* C, int ldc, int M, int N, int K) {
    int n = blockIdx.x % ((N + 63) / 64) * 64 + (threadIdx.x & 63);
    int m0 = (blockIdx.x / ((N + 63) / 64) * (blockDim.x / 64) + (threadIdx.x >> 6)) * 4;
    if (n >= N || m0 >= M) return;
    float c0 = 0, c1 = 0, c2 = 0, c3 = 0;
    const float* a = A + (size_t)m0 * lda;
    for (int k = 0; k < K; ++k) { float b = B[(size_t)k * ldb + n]; c0 += a[k] * b; c1 += a[lda + k] * b; c2 += a[2 * lda + k] * b; c3 += a[3 * lda + k] * b; }
    stc<TC>(C + (size_t)m0 * ldc + n, c0); stc<TC>(C + (size_t)(m0 + 1) * ldc + n, c1); stc<TC>(C + (size_t)(m0 + 2) * ldc + n, c2); stc<TC>(C + (size_t)(m0 + 3) * ldc + n, c3);
}

__global__ void k_lb(const float* logits, float* lb) {
    int i = blockIdx.x * blockDim.x + threadIdx.x; if (i >= 768) return;
    float a = logits[i], b = logits[768 + i], m = fmaxf(a, b), ea = expf(a - m), eb = expf(b - m);
    float p0 = ea / (ea + eb), p1 = eb / (ea + eb);
    lb[i] = p0 - p0; lb[768 + i] = (p0 + p1) - p0;
}

__global__ void k_gla_alogit(const pt* proj, const float* wa2, const float* ba, float* AL) {
    size_t idx = (size_t)blockIdx.x * blockDim.x + threadIdx.x; if (idx >= (size_t)2 * T * 192) return;
    int j = idx % 192; size_t r = idx / 192; int t = r % T, d = r / T;
    float a = ba[d * 192 + j];
    for (int rr = 0; rr < 16; ++rr) a += ldp(proj + (size_t)t * DIN + C_GA + d * 16 + rr) * wa2[(d * 16 + rr) * 192 + j];
    AL[idx] = expf(logsigmoidf_(a) * (1.0f / 16.0f));
}

__global__ void k_scan_gla(const pt* proj, const float* AL, float* mixin) {
    int id = blockIdx.x * blockDim.x + threadIdx.x; if (id >= NB * 6 * 64 * 2) return;
    int v = id & 63, h = (id >> 6) % 6, b = (id / 384) % NB, dir = id / (384 * NB);
    const float qs = 0.17677669529663687f;
    {
        float S[32];
#pragma unroll
        for (int k = 0; k < 32; ++k) S[k] = 0.f;
        for (int i = 0; i < L; ++i) {
            int t = dir ? L - 1 - i : i; size_t row = (size_t)b * L + t; const pt* pr = proj + row * DIN;
            float vv = ldp(pr + C_GV + h * 64 + v), o = 0.f;
            const float* al = AL + ((size_t)dir * T + row) * 192 + h * 32;
#pragma unroll
            for (int k = 0; k < 32; ++k) {
                float a = al[k];
                S[k] = a * S[k] + ldp(pr + C_GK + h * 32 + k) * vv;
                o += ldp(pr + C_GQ + h * 32 + k) * qs * S[k];
            }
            atomicAdd(mixin + row * DM + h * 64 + v, o);
        }
    }
}
__global__ void k_scan_hg(const pt* proj, const float* lb  , float* mixin) {
    int id = blockIdx.x * blockDim.x + threadIdx.x; if (id >= NB * 6 * 64 * 2) return;
    int v = id & 63, h = (id >> 6) % 6, b = (id / 384) % NB, dir = id / (384 * NB);
    {
        float S[64];
#pragma unroll
        for (int k = 0; k < 64; ++k) S[k] = 0.f;
        for (int i = 0; i < L; ++i) {
            int t = dir ? L - 1 - i : i; size_t row = (size_t)b * L + t; const pt* pr = proj + row * DIN;
            float vv = ldp(pr + C_HI + h * 64 + v), o = 0.f;
#pragma unroll
            for (int k = 0; k < 64; ++k) {
                float z = ldp(pr + C_HF + dir * 384 + h * 64 + k), l_ = lb[dir * 384 + h * 64 + k];
                float sg = sigmoidf_(z), a = l_ + (1.f - l_) * sg, kk = (1.f - l_) * (1.f - sg);
                S[k] = a * S[k] + kk * vv;
                o += siluf_(ldp(pr + C_HQ + h * 64 + k)) * S[k];
            }
            atomicAdd(mixin + row * DM + 384 + h * 64 + v, o);
        }
    }
}
__global__ void k_headnorm(const pt* proj, const float* gla_g, const float* hg_g, float* mixin) {
    int id = blockIdx.x * blockDim.x + threadIdx.x; if (id >= T * 12) return;
    int hh = id % 12, t = id / 12; float* o = mixin + (size_t)t * DM + hh * 64;
    float q = 0.f; for (int j = 0; j < 64; ++j) q += o[j] * o[j];
    float r = 1.0f / sqrtf(q / 64.f + RMS_EPS);
    for (int j = 0; j < 64; ++j) {
        float gate, g;
        if (hh < 6) { gate = siluf_(ldp(proj + (size_t)t * DIN + C_GG + hh * 64 + j)); g = gla_g[hh * 64 + j]; }
        else { gate = sigmoidf_(ldp(proj + (size_t)t * DIN + C_HGT + (hh - 6) * 64 + j)); g = hg_g[(hh - 6) * 64 + j]; }
        o[j] = o[j] * r * g * gate;
    }
}

__device__ __forceinline__ float hy_feat(int n, int i) {
    if (i == 0) return (float)n / (float)(L - 1);
    float w = 6.283185307179586f * (float)n / (float)L;
    int bi = (i - 1) & 15; float band = 1e-4f + (float)bi * ((15.0f - 1e-4f) / 15.0f);
    return (i <= 16) ? cosf(band * w) : -sinf(band * w);
}
__global__ void k_hy_mlp1(const float* w1, const float* b1, const float* freq, float* hout) {
    int id = blockIdx.x * blockDim.x + threadIdx.x; if (id >= L * 64) return;
    int j = id & 63, n = id >> 6; float a = b1[j];
    for (int i = 0; i < 33; ++i) a += hy_feat(n, i) * w1[i * 64 + j];
    hout[id] = sinf(freq[j] * a);
}
__global__ void k_hy_mlp2(const float* hin, const float* w2, const float* b2, const float* freq, float* hout) {
    int id = blockIdx.x * blockDim.x + threadIdx.x; if (id >= L * 64) return;
    int j = id & 63, n = id >> 6; float a = b2[j];
    for (int i = 0; i < 64; ++i) a += hin[n * 64 + i] * w2[i * 64 + j];
    hout[id] = sinf(freq[j] * a);
}
__global__ void k_hy_filt(const float* hin, const float* w3, float* HF) {
    int id = blockIdx.x * blockDim.x + threadIdx.x; if (id >= L * 1024) return;
    int col = id & 1023, n = id >> 10, c = col & 255, od = col >> 8;
    float a = 0.f;
    for (int i = 0; i < 64; ++i) a += hin[n * 64 + i] * w3[i * 1024 + col];
    const float mind = -3.0701134573253944f, maxd = -15.350567286626972f;
    float delta = mind + (float)c * ((maxd - mind) / 255.0f);
    float tn = (float)n / (float)(L - 1);
    HF[((size_t)od * L + n) * 256 + c] = a * expf(-tn * fabsf(delta));
}
__global__ void k_hy_norm(const float* HF, float* invn) {
    int id = blockIdx.x * blockDim.x + threadIdx.x; if (id >= 512) return;
    int c = id & 255, o = id >> 8; float s = 0.f;
    for (int n = 0; n < L; ++n) s += fabsf(HF[((size_t)(o * 2 + 0) * L + n) * 256 + c]);
    for (int n = 1; n < L; ++n) s += fabsf(HF[((size_t)(o * 2 + 1) * L + n) * 256 + c]);
    invn[id] = 1.0f / fmaxf(s, 1e-12f);
}
__global__ void k_hy_short(const pt* proj, const float* cw, const float* cb, pt* u2) {
    size_t id = (size_t)blockIdx.x * blockDim.x + threadIdx.x; if (id >= (size_t)T * 768) return;
    int c = id % 768; size_t row = id / 768; int t = row % L;
    float a = cb[c];
    for (int j = 0; j < 3; ++j) { int tt = t + j - 1; if (tt >= 0 && tt < L) a += cw[j * 768 + c] * ldp(proj + (row + j - 1) * DIN + C_HY + c); }
    stp(u2 + id, a);
}
template <class TZ> __device__ __forceinline__ float ldz(const TZ* p);
template <> __device__ __forceinline__ float ldz<float>(const float* p) { return *p; }
#ifndef CPU_EMU
template <> __device__ __forceinline__ float ldz<pt>(const pt* p) { return ldp(p); }
#endif
template <class TZ> __global__ void k_hy_conv(const TZ* z, int zs, const pt* gate, int gs, const float* HFo  , const float* invn, const float* bias, float* out, int os) {
    size_t id = (size_t)blockIdx.x * blockDim.x + threadIdx.x; if (id >= (size_t)T * 256) return;
    int c = id & 255; size_t row = id >> 8; int t = row % L; size_t r0 = row - t;
    float a = 0.f;
    for (int s = 0; s <= t; ++s) a += HFo[(size_t)(t - s) * 256 + c] * ldz<TZ>(z + (r0 + s) * zs + c);
    for (int s = t + 1; s < L; ++s) a += HFo[((size_t)L + (s - t)) * 256 + c] * ldz<TZ>(z + (r0 + s) * zs + c);
    float zc = ldz<TZ>(z + row * zs + c);
    out[row * os + c] = ldp(gate + row * gs + c) * (a * invn[c] + zc * bias[c]);
}

__global__ void k_route(const float* h, const float* wrg, const float* brg, const float* wre, const float* bre, int* E, float* W) {
    int t = blockIdx.x * blockDim.x + threadIdx.x; if (t >= T) return;
    const float* x = h + (size_t)t * DM;
    float lg0 = brg[0], lg1 = brg[1], lg2 = brg[2], lg3 = brg[3];
    for (int i = 0; i < DM; ++i) { float xi = x[i]; lg0 += xi * wrg[i * 4]; lg1 += xi * wrg[i * 4 + 1]; lg2 += xi * wrg[i * 4 + 2]; lg3 += xi * wrg[i * 4 + 3]; }
    int gi = 0; float gm = lg0;
    if (lg1 > gm) { gm = lg1; gi = 1; } if (lg2 > gm) { gm = lg2; gi = 2; } if (lg3 > gm) { gm = lg3; gi = 3; }
    float sg = expf(lg0 - gm) + expf(lg1 - gm) + expf(lg2 - gm) + expf(lg3 - gm);
    float gval = 1.0f / sg;
    float le0 = bre[gi * 4], le1 = bre[gi * 4 + 1], le2 = bre[gi * 4 + 2], le3 = bre[gi * 4 + 3];
    for (int i = 0; i < DM; ++i) { float xi = x[i]; const float* w = wre + i * 16 + gi * 4; le0 += xi * w[0]; le1 += xi * w[1]; le2 += xi * w[2]; le3 += xi * w[3]; }
    int e0 = 0; float v0 = le0;
    if (le1 > v0) { v0 = le1; e0 = 1; } if (le2 > v0) { v0 = le2; e0 = 2; } if (le3 > v0) { v0 = le3; e0 = 3; }
    int e1 = -1; float v1 = -3.0e38f;
    if (e0 != 0 && le0 > v1) { v1 = le0; e1 = 0; } if (e0 != 1 && le1 > v1) { v1 = le1; e1 = 1; }
    if (e0 != 2 && le2 > v1) { v1 = le2; e1 = 2; } if (e0 != 3 && le3 > v1) { v1 = le3; e1 = 3; }
    float p1 = expf(v1 - v0);
    float w0 = 1.0f / (1.0f + p1), w1 = p1 / (1.0f + p1);
    E[t * 2] = gi * 4 + e0; E[t * 2 + 1] = gi * 4 + e1; W[t * 2] = gval * w0; W[t * 2 + 1] = gval * w1;
}
__global__ void k_moe_hid(const float* h, const int* E, const float* wg, const float* wu, float* hid) {
    size_t id = (size_t)blockIdx.x * blockDim.x + threadIdx.x; if (id >= (size_t)T * 2 * 512) return;
    int j = id & 511; size_t a = id >> 9; int t = a >> 1; int e = E[a];
    const float* x = h + (size_t)t * DM; const float* g = wg + (size_t)e * DM * 512 + j; const float* u = wu + (size_t)e * DM * 512 + j;
    float sg = 0.f, su = 0.f;
    for (int i = 0; i < DM; ++i) { sg += x[i] * g[(size_t)i * 512]; su += x[i] * u[(size_t)i * 512]; }
    hid[id] = siluf_(sg) * su;
}
__global__ void k_moe_down(const float* hid, const int* E, const float* W, const float* wd, float* y) {
    size_t id = (size_t)blockIdx.x * blockDim.x + threadIdx.x; if (id >= (size_t)T * DM) return;
    int n = id & 1023; int t = id >> 10; float acc = 0.f;
    for (int kk = 0; kk < 2; ++kk) {
        int e = E[t * 2 + kk]; const float* hrow = hid + ((size_t)t * 2 + kk) * 512; const float* w = wd + (size_t)e * 512 * DM + n;
        float s = 0.f; for (int j = 0; j < 512; ++j) s += hrow[j] * w[(size_t)j * DM];
        acc += W[t * 2 + kk] * s;
    }
    y[id] = acc;
}

__global__ void k_zero(float* p, size_t n) { size_t i = (size_t)blockIdx.x * blockDim.x + threadIdx.x; if (i < n) p[i] = 0.f; }
static inline size_t al256(size_t x) { return (x + 255) & ~(size_t)255; }
extern "C" void kernel_launch(void* const* d_in, const int* in_sizes, int n_in, void* d_out, int out_size, void* d_ws, size_t ws_size, hipStream_t stream) {
    const float* x = (const float*)d_in[0];
    const float *ln_in_g = (const float*)d_in[1], *ln_in_b = (const float*)d_in[2], *w_in = (const float*)d_in[3], *gla_wa2 = (const float*)d_in[4], *gla_ba = (const float*)d_in[5],
                *gla_norm_g = (const float*)d_in[6], *hg_lb_logits = (const float*)d_in[7], *hg_norm_g = (const float*)d_in[8], *hy_conv_w = (const float*)d_in[9], *hy_conv_b = (const float*)d_in[10],
                *hy_w1 = (const float*)d_in[11], *hy_b1 = (const float*)d_in[12], *hy_freq = (const float*)d_in[13], *hy_w2 = (const float*)d_in[14], *hy_b2 = (const float*)d_in[15],
                *hy_w3 = (const float*)d_in[16], *hy_bias = (const float*)d_in[17], *w_out = (const float*)d_in[18], *ln1_g = (const float*)d_in[19], *ln1_b = (const float*)d_in[20],
                *moe_wr_g = (const float*)d_in[21], *moe_br_g = (const float*)d_in[22], *moe_wr_e = (const float*)d_in[23], *moe_br_e = (const float*)d_in[24], *moe_w_gate = (const float*)d_in[25],
                *moe_w_up = (const float*)d_in[26], *moe_w_down = (const float*)d_in[27], *ln2_g = (const float*)d_in[28], *ln2_b = (const float*)d_in[29];
    float* H = (float*)d_out;
    char* ws = (char*)d_ws; size_t off = 0;
    auto take = [&](size_t bytes) { char* p = ws + off; off = al256(off + bytes); return p; };
    pt* PROJ = (pt*)take((size_t)T * DIN * sizeof(pt));
    float* MIXIN = (float*)take((size_t)T * DM * 4);
    char* r2 = ws + off;
    pt* U2 = (pt*)take((size_t)T * 768 * sizeof(pt));
    float* Z1 = (float*)take((size_t)T * 256 * 4);
    float* AL = (float*)r2;
    { size_t need = (size_t)2 * T * 192 * 4; size_t have = (size_t)(ws + off - r2); if (need > have) take(need - have); }
    float* HF = (float*)take((size_t)4 * L * 256 * 4);
    float* HA = (float*)take((size_t)L * 64 * 4); float* HB = (float*)take((size_t)L * 64 * 4);
    float* INVN = (float*)take(512 * 4); float* LB = (float*)take(2 * 768 * 4);
    int* RE = (int*)take((size_t)T * 2 * 4); float* RW = (float*)take((size_t)T * 2 * 4);
    if (off > ws_size) return;
    float* MIX = (float*)ws;
    float* HID = (float*)ws; float* Y = (float*)(ws + (size_t)T * DM * 4);
    if ((size_t)T * DM * 8 > (size_t)((char*)RE - ws)) return;

    LAUNCH(k_lb, 3, 256, stream, hg_lb_logits, LB);
    LAUNCH(k_ln, (T + 63) / 64, 64, stream, x, (const float*)nullptr, 1.0f, ln_in_g, ln_in_b, H, T);
    for (int l = 0; l < DEPTH; ++l) {
        LAUNCH(k_hy_mlp1, L * 64 / 256, 256, stream, hy_w1 + l * 33 * 64, hy_b1 + l * 64, hy_freq + l * 64, HA);
        LAUNCH(k_hy_mlp2, L * 64 / 256, 256, stream, (const float*)HA, hy_w2 + (l * 2 + 0) * 4096, hy_b2 + (l * 2 + 0) * 64, hy_freq + l * 64, HB);
        LAUNCH(k_hy_mlp2, L * 64 / 256, 256, stream, (const float*)HB, hy_w2 + (l * 2 + 1) * 4096, hy_b2 + (l * 2 + 1) * 64, hy_freq + l * 64, HA);
        LAUNCH(k_hy_filt, L * 1024 / 256, 256, stream, (const float*)HA, hy_w3 + (size_t)l * 64 * 1024, HF);
        LAUNCH(k_hy_norm, 2, 256, stream, (const float*)HF, INVN);
        { int nb = (DIN + 63) / 64, mb = T / 16; LAUNCH(k_gemm<pt>, nb * mb, 256, stream, (const float*)H, DM, w_in + (size_t)l * DM * DIN, DIN, PROJ, DIN, T, DIN, DM); }
        LAUNCH(k_zero, (size_t)T * DM / 256, 256, stream, MIXIN, (size_t)T * DM);
        LAUNCH(k_hy_short, (size_t)T * 768 / 256, 256, stream, (const pt*)PROJ, hy_conv_w + l * 3 * 768, hy_conv_b + l * 768, U2);
        LAUNCH(k_hy_conv<pt>, T, 256, stream, (const pt*)U2, 768, (const pt*)(U2 + 256), 768, (const float*)HF, (const float*)INVN, hy_bias + (l * 2 + 0) * 256, Z1, 256);
        LAUNCH(k_hy_conv<float>, T, 256, stream, (const float*)Z1, 256, (const pt*)(U2 + 512), 768, (const float*)(HF + (size_t)2 * L * 256), (const float*)(INVN + 256), hy_bias + (l * 2 + 1) * 256, MIXIN + 768, DM);
        LAUNCH(k_gla_alogit, ((size_t)2 * T * 192 + 255) / 256, 256, stream, (const pt*)PROJ, gla_wa2 + l * 2 * 16 * 192, gla_ba + l * 2 * 192, AL);
        LAUNCH(k_scan_gla, NB * 6 * 2, 64, stream, (const pt*)PROJ, (const float*)AL, MIXIN);
        LAUNCH(k_scan_hg, NB * 6 * 2, 64, stream, (const pt*)PROJ, (const float*)(LB + l * 768), MIXIN);
        LAUNCH(k_headnorm, (T * 12 + 255) / 256, 256, stream, (const pt*)PROJ, gla_norm_g + l * 384, hg_norm_g + l * 384, MIXIN);
        { int nb = DM / 64, mb = T / 16; LAUNCH(k_gemm<float>, nb * mb, 256, stream, (const float*)MIXIN, DM, w_out + (size_t)l * DM * DM, DM, MIX, DM, T, DM, DM); }
        LAUNCH(k_ln, (T + 63) / 64, 64, stream, (const float*)H, (const float*)MIX, ALPHA, ln1_g + l * DM, ln1_b + l * DM, H, T);
        LAUNCH(k_route, (T + 63) / 64, 64, stream, (const float*)H, moe_wr_g + l * DM * 4, moe_br_g + l * 4, moe_wr_e + l * DM * 16, moe_br_e + l * 16, RE, RW);
        LAUNCH(k_moe_hid, (size_t)T * 1024 / 256, 256, stream, (const float*)H, (const int*)RE, moe_w_gate + (size_t)l * 16 * DM * 512, moe_w_up + (size_t)l * 16 * DM * 512, HID);
        LAUNCH(k_moe_down, (size_t)T * DM / 256, 256, stream, (const float*)HID, (const int*)RE, (const float*)RW, moe_w_down + (size_t)l * 16 * 512 * DM, Y);
        LAUNCH(k_ln, (T + 63) / 64, 64, stream, (const float*)H, (const float*)Y, ALPHA, ln2_g + l * DM, ln2_b + l * DM, H, T);
    }
}
```

```cpp
#ifndef CPU_EMU
#include <hip/hip_runtime.h>
#include <hip/hip_cooperative_groups.h>
#include <cstdio>
namespace cg = cooperative_groups;
#endif
#include <cstdint>
#include <cstddef>
#include <type_traits>

#ifndef SEQ_
#define SEQ_ 8192
#endif
#ifndef BATCH_
#define BATCH_ 4
#endif
#ifndef OPT_GEMM
#define OPT_GEMM 1
#endif
#ifndef OPT_MOE
#define OPT_MOE 1
#endif
#ifndef OPT_HY
#define OPT_HY 1
#endif
#ifndef OPT_SCAN
#define OPT_SCAN 1
#endif
#ifndef OPT_EW
#define OPT_EW 1
#endif
#ifndef PROBE_MASK
#define PROBE_MASK 0
#endif
constexpr int DM = 1024, NB = BATCH_, L = SEQ_, T = NB * L, DEPTH = 2, DIN = 3872, NP = 4096;
#ifdef CPU_EMU
constexpr int NPS = NP;
#else
constexpr int NPS = NP;
#endif
constexpr int C_GV = 0, C_HI = 384, C_HY = 768, C_GQ = 1536, C_GK = 1728, C_GG = 1920, C_HQ = 2304, C_HF = 2688, C_HGT = 3456, C_GA = 3840;
__host__ __device__ __forceinline__ int oldcol(int n) {
    return n < 384 ? 384 + n : n < 768 ? 2336 + (n - 384) : n < 1536 ? 3104 + (n - 768) : n < 1728 ? (n - 1536) : n < 1920 ? 192 + (n - 1728) : n < 2304 ? 768 + (n - 1920)
         : n < 2688 ? 1184 + (n - 2304) : n < 3456 ? 1568 + (n - 2688) : n < 3840 ? 2720 + (n - 3456) : 1152 + (n - 3840);
}
constexpr float ALPHA = 1.41421356237f, LN_EPS = 1e-5f, RMS_EPS = 1e-6f;

#ifdef CPU_EMU
typedef float pt;
__device__ __forceinline__ float ldp(const pt* p) { return *p; }
__device__ __forceinline__ void stp(pt* p, float v) { *p = v; }
#define FEXP(x) expf(x)
#define FDIV(a, b) ((a) / (b))
#else
typedef unsigned short pt;
__device__ __forceinline__ float ldp(const pt* p) { return __uint_as_float(((unsigned)*p) << 16); }
__device__ __forceinline__ unsigned f2bf(float v) { unsigned u = __float_as_uint(v); return (u + 0x7fffu + ((u >> 16) & 1u)) >> 16; }
__device__ __forceinline__ void stp(pt* p, float v) { *p = (pt)f2bf(v); }
#define FEXP(x) __expf(x)
#define FDIV(a, b) __fdividef(a, b)
#endif
__device__ __forceinline__ float sigmoidf_(float x) { return FDIV(1.0f, 1.0f + FEXP(-x)); }
__device__ __forceinline__ float siluf_(float x) { return FDIV(x, 1.0f + FEXP(-x)); }
__device__ __forceinline__ float logsigmoidf_(float x) { return fminf(x, 0.f) - log1pf(expf(-fabsf(x))); }

__device__ __forceinline__ void d_k_ln(const float* a, const float* b, float alpha, const float* g, const float* be, float* out, pt* xb, size_t id_) {
    int r = (int)id_;
    const float* ar = a + (size_t)r * DM; const float* br = b ? b + (size_t)r * DM : nullptr;
    float s = 0.f;
    for (int i = 0; i < DM; ++i) s += alpha * ar[i] + (br ? br[i] : 0.f);
    float mean = s / DM, q = 0.f;
    for (int i = 0; i < DM; ++i) { float d = alpha * ar[i] + (br ? br[i] : 0.f) - mean; q += d * d; }
    float rstd = 1.0f / sqrtf(q / DM + LN_EPS);
    float* o = out + (size_t)r * DM; pt* ob = xb + (size_t)r * DM;
    for (int i = 0; i < DM; ++i) { float v = alpha * ar[i] + (br ? br[i] : 0.f); float y = (v - mean) * rstd * g[i] + be[i]; o[i] = y; stp(ob + i, y); }
}
__device__ __forceinline__ void d_k_inproj(const float* A, const float* B, pt* C, size_t id_) {
    int n = (int)(id_ % (size_t)DIN); int m0 = (int)(id_ / (size_t)DIN) * 4; int oc = oldcol(n);
    float c0 = 0, c1 = 0, c2 = 0, c3 = 0; const float* a = A + (size_t)m0 * DM;
    for (int k = 0; k < DM; ++k) { float bb = B[(size_t)k * DIN + oc]; c0 += a[k] * bb; c1 += a[DM + k] * bb; c2 += a[2 * DM + k] * bb; c3 += a[3 * DM + k] * bb; }
    stp(C + (size_t)m0 * NPS + n, c0); stp(C + (size_t)(m0 + 1) * NPS + n, c1); stp(C + (size_t)(m0 + 2) * NPS + n, c2); stp(C + (size_t)(m0 + 3) * NPS + n, c3);
}
__device__ __forceinline__ void d_k_outproj(const pt* A, const float* B, float* C, size_t id_) {
    int n = (int)(id_ % (size_t)DM); int m0 = (int)(id_ / (size_t)DM) * 4;
    float c0 = 0, c1 = 0, c2 = 0, c3 = 0; const pt* a = A + (size_t)m0 * DM;
    for (int k = 0; k < DM; ++k) { float bb = B[(size_t)k * DM + n]; c0 += ldp(a + k) * bb; c1 += ldp(a + DM + k) * bb; c2 += ldp(a + 2 * DM + k) * bb; c3 += ldp(a + 3 * DM + k) * bb; }
    C[(size_t)m0 * DM + n] = c0; C[(size_t)(m0 + 1) * DM + n] = c1; C[(size_t)(m0 + 2) * DM + n] = c2; C[(size_t)(m0 + 3) * DM + n] = c3;
}
__device__ __forceinline__ void d_k_lb(const float* logits, float* lb, size_t id_) {
    int i = (int)id_;
    float a = logits[i], b = logits[768 + i], m = fmaxf(a, b), ea = expf(a - m), eb = expf(b - m);
    float p0 = ea / (ea + eb), p1 = eb / (ea + eb);
    lb[i] = p0 - p0; lb[768 + i] = (p0 + p1) - p0;
}
__device__ __forceinline__ void d_k_gla_alogit(const pt* proj, const float* wa2, const float* ba, pt* AL, size_t id_) {
    size_t idx = (size_t)id_;
    int j = idx % 192; size_t r = idx / 192; int t = r % T, d = r / T;
    float a = ba[d * 192 + j];
    for (int rr = 0; rr < 16; ++rr) a += ldp(proj + (size_t)t * NPS + C_GA + d * 16 + rr) * wa2[(d * 16 + rr) * 192 + j];
    stp(AL + idx, logsigmoidf_(a) * (1.0f / 16.0f));
}
__device__ __forceinline__ void d_k_scan_gla(const pt* proj, const pt* AL, pt* mixin, size_t id_) {
    int id = (int)id_;
    int v = id & 63, h = (id >> 6) % 6, b = id / 384;
    const float qs = 0.17677669529663687f;
    for (int dir = 0; dir < 2; ++dir) {
        float S[32];
#pragma unroll
        for (int k = 0; k < 32; ++k) S[k] = 0.f;
        for (int i = 0; i < L; ++i) {
            int t = dir ? L - 1 - i : i; size_t row = (size_t)b * L + t; const pt* pr = proj + row * NPS;
            float vv = ldp(pr + C_GV + h * 64 + v), o = 0.f;
            const pt* al = AL + ((size_t)dir * T + row) * 192 + h * 32;
#pragma unroll
            for (int k = 0; k < 32; ++k) {
                float a = FEXP(ldp(al + k));
                S[k] = a * S[k] + ldp(pr + C_GK + h * 32 + k) * vv;
                o += ldp(pr + C_GQ + h * 32 + k) * qs * S[k];
            }
            pt* op = mixin + row * DM + h * 64 + v;
            if (dir == 0) stp(op, o); else stp(op, ldp(op) + o);
        }
    }
}
__device__ __forceinline__ void d_k_scan_hg(const pt* proj, const float* lb  , pt* mixin, size_t id_) {
    int id = (int)id_;
    int v = id & 63, h = (id >> 6) % 6, b = id / 384;
    for (int dir = 0; dir < 2; ++dir) {
        float S[64];
#pragma unroll
        for (int k = 0; k < 64; ++k) S[k] = 0.f;
        for (int i = 0; i < L; ++i) {
            int t = dir ? L - 1 - i : i; size_t row = (size_t)b * L + t; const pt* pr = proj + row * NPS;
            float vv = ldp(pr + C_HI + h * 64 + v), o = 0.f;
#pragma unroll
            for (int k = 0; k < 64; ++k) {
                float z = ldp(pr + C_HF + dir * 384 + h * 64 + k), l_ = lb[dir * 384 + h * 64 + k];
                float sg = sigmoidf_(z), a = l_ + (1.f - l_) * sg, kk = (1.f - l_) * (1.f - sg);
                S[k] = a * S[k] + kk * vv;
                o += siluf_(ldp(pr + C_HQ + h * 64 + k)) * S[k];
            }
            pt* op = mixin + row * DM + 384 + h * 64 + v;
            if (dir == 0) stp(op, o); else stp(op, ldp(op) + o);
        }
    }
}
__device__ __forceinline__ void d_k_headnorm(const pt* proj, const float* gla_g, const float* hg_g, pt* mixin, size_t id_) {
    int id = (int)id_;
    int hh = id % 12, t = id / 12; pt* o = mixin + (size_t)t * DM + hh * 64;
    float q = 0.f; for (int j = 0; j < 64; ++j) { float v = ldp(o + j); q += v * v; }
    float r = 1.0f / sqrtf(q / 64.f + RMS_EPS);
    for (int j = 0; j < 64; ++j) {
        float gate, g;
        if (hh < 6) { gate = siluf_(ldp(proj + (size_t)t * NPS + C_GG + hh * 64 + j)); g = gla_g[hh * 64 + j]; }
        else { gate = sigmoidf_(ldp(proj + (size_t)t * NPS + C_HGT + (hh - 6) * 64 + j)); g = hg_g[(hh - 6) * 64 + j]; }
        stp(o + j, ldp(o + j) * r * g * gate);
    }
}
__device__ __forceinline__ float hy_feat(int n, int i) {
    if (i == 0) return (float)n / (float)(L - 1);
    float w = 6.283185307179586f * (float)n / (float)L;
    int bi = (i - 1) & 15; float band = 1e-4f + (float)bi * ((15.0f - 1e-4f) / 15.0f);
    return (i <= 16) ? cosf(band * w) : -sinf(band * w);
}
__device__ __forceinline__ void d_k_hy_mlp1(const float* w1, const float* b1, const float* freq, float* hout, size_t id_) {
    int id = (int)id_;
    int j = id & 63, n = id >> 6; float a = b1[j];
    for (int i = 0; i < 33; ++i) a += hy_feat(n, i) * w1[i * 64 + j];
    hout[id] = sinf(freq[j] * a);
}
__device__ __forceinline__ void d_k_hy_mlp2(const float* hin, const float* w2, const float* b2, const float* freq, float* hout, size_t id_) {
    int id = (int)id_;
    int j = id & 63, n = id >> 6; float a = b2[j];
    for (int i = 0; i < 64; ++i) a += hin[n * 64 + i] * w2[i * 64 + j];
    hout[id] = sinf(freq[j] * a);
}
__device__ __forceinline__ void d_k_hy_filt(const float* hin, const float* w3, float* HF, size_t id_) {
    int id = (int)id_;
    int col = id & 1023, n = id >> 10, c = col & 255, od = col >> 8;
    float a = 0.f;
    for (int i = 0; i < 64; ++i) a += hin[n * 64 + i] * w3[i * 1024 + col];
    const float mind = -3.0701134573253944f, maxd = -15.350567286626972f;
    float delta = mind + (float)c * ((maxd - mind) / 255.0f);
    float tn = (float)n / (float)(L - 1);
    HF[((size_t)od * L + n) * 256 + c] = a * expf(-tn * fabsf(delta));
}
__device__ __forceinline__ void d_k_hy_norm(const float* HF, float* invn, size_t id_) {
    int id = (int)id_;
    int c = id & 255, o = id >> 8; float s = 0.f;
    for (int n = 0; n < L; ++n) s += fabsf(HF[((size_t)(o * 2 + 0) * L + n) * 256 + c]);
    for (int n = 1; n < L; ++n) s += fabsf(HF[((size_t)(o * 2 + 1) * L + n) * 256 + c]);
    invn[id] = 1.0f / fmaxf(s, 1e-12f);
}
__device__ __forceinline__ void d_k_hy_short(const pt* proj, const float* cw, const float* cb, pt* u2, size_t id_) {
    size_t id = (size_t)id_;
    int c = id % 768; size_t row = id / 768; int t = row % L;
    float a = cb[c];
    for (int j = 0; j < 3; ++j) { int tt = t + j - 1; if (tt >= 0 && tt < L) a += cw[j * 768 + c] * ldp(proj + (row + j - 1) * NPS + C_HY + c); }
    stp(u2 + id, a);
}
__device__ __forceinline__ void d_k_hy_conv(const pt* z, int zs, const pt* gate, int gs, const float* HFo  , const float* invn, const float* bias, pt* out, int os, size_t id_) {
    size_t id = (size_t)id_;
    int c = id & 255; size_t row = id >> 8; int t = row % L; size_t r0 = row - t;
    float a = 0.f;
    for (int s = 0; s <= t; ++s) a += HFo[(size_t)(t - s) * 256 + c] * ldp(z + (r0 + s) * zs + c);
    for (int s = t + 1; s < L; ++s) a += HFo[((size_t)L + (s - t)) * 256 + c] * ldp(z + (r0 + s) * zs + c);
    float zc = ldp(z + row * zs + c);
    stp(out + row * os + c, ldp(gate + row * gs + c) * (a * invn[c] + zc * bias[c]));
}
__device__ __forceinline__ void d_k_route(const float* h, const float* wrg, const float* brg, const float* wre, const float* bre, int* E, float* W, int* CNT, size_t id_) {
    int t = (int)id_;
    const float* x = h + (size_t)t * DM;
    float lg0 = brg[0], lg1 = brg[1], lg2 = brg[2], lg3 = brg[3];
    for (int i = 0; i < DM; ++i) { float xi = x[i]; lg0 += xi * wrg[i * 4]; lg1 += xi * wrg[i * 4 + 1]; lg2 += xi * wrg[i * 4 + 2]; lg3 += xi * wrg[i * 4 + 3]; }
    int gi = 0; float gm = lg0;
    if (lg1 > gm) { gm = lg1; gi = 1; } if (lg2 > gm) { gm = lg2; gi = 2; } if (lg3 > gm) { gm = lg3; gi = 3; }
    float sg = expf(lg0 - gm) + expf(lg1 - gm) + expf(lg2 - gm) + expf(lg3 - gm);
    float gval = 1.0f / sg;
    float le0 = bre[gi * 4], le1 = bre[gi * 4 + 1], le2 = bre[gi * 4 + 2], le3 = bre[gi * 4 + 3];
    for (int i = 0; i < DM; ++i) { float xi = x[i]; const float* w = wre + i * 16 + gi * 4; le0 += xi * w[0]; le1 += xi * w[1]; le2 += xi * w[2]; le3 += xi * w[3]; }
    int e0 = 0; float v0 = le0;
    if (le1 > v0) { v0 = le1; e0 = 1; } if (le2 > v0) { v0 = le2; e0 = 2; } if (le3 > v0) { v0 = le3; e0 = 3; }
    int e1 = -1; float v1 = -3.0e38f;
    if (e0 != 0 && le0 > v1) { v1 = le0; e1 = 0; } if (e0 != 1 && le1 > v1) { v1 = le1; e1 = 1; }
    if (e0 != 2 && le2 > v1) { v1 = le2; e1 = 2; } if (e0 != 3 && le3 > v1) { v1 = le3; e1 = 3; }
    float p1 = expf(v1 - v0);
    float w0 = 1.0f / (1.0f + p1), w1 = p1 / (1.0f + p1);
    E[t * 2] = gi * 4 + e0; E[t * 2 + 1] = gi * 4 + e1; W[t * 2] = gval * w0; W[t * 2 + 1] = gval * w1;
    atomicAdd(CNT + gi * 4 + e0, 1); atomicAdd(CNT + gi * 4 + e1, 1);
}
__device__ __forceinline__ void d_k_moe_hid(const float* h, const int* E, const float* wg, const float* wu, float* hid, size_t id_) {
    size_t id = (size_t)id_;
    int j = id & 511; size_t a = id >> 9; int t = a >> 1; int e = E[a];
    const float* x = h + (size_t)t * DM; const float* g = wg + (size_t)e * DM * 512 + j; const float* u = wu + (size_t)e * DM * 512 + j;
    float sg = 0.f, su = 0.f;
    for (int i = 0; i < DM; ++i) { sg += x[i] * g[(size_t)i * 512]; su += x[i] * u[(size_t)i * 512]; }
    hid[id] = siluf_(sg) * su;
}
__device__ __forceinline__ void d_k_moe_down(const float* hid, const int* E, const float* W, const float* wd, float* y, size_t id_) {
    size_t id = (size_t)id_;
    int n = id & 1023; int t = id >> 10; float acc = 0.f;
    for (int kk = 0; kk < 2; ++kk) {
        int e = E[t * 2 + kk]; const float* hrow = hid + ((size_t)t * 2 + kk) * 512; const float* w = wd + (size_t)e * 512 * DM + n;
        float s = 0.f; for (int j = 0; j < 512; ++j) s += hrow[j] * w[(size_t)j * DM];
        acc += W[t * 2 + kk] * s;
    }
    y[id] = acc;
}


constexpr int RFL = 2 * L + 384;
__device__ __forceinline__ void d_k_hy_prep(const pt* proj, const float* cw, const float* cb, pt* u2t, size_t id_) {
    size_t id = (size_t)id_; int t = (int)(id % L); size_t bc = id / L; int c = (int)(bc % 768); size_t b = bc / 768; size_t row = b * L + t;
    float a = cb[c];
    for (int j = 0; j < 3; ++j) { int tt = t + j - 1; if (tt >= 0 && tt < L) a += cw[j * 768 + c] * ldp(proj + (row + j - 1) * NPS + C_HY + c); }
    stp(u2t + id, a);
}
__device__ __forceinline__ void d_k_hy_rf(const float* HF, pt* RFs, size_t id_) {
    size_t id = (size_t)id_; int idx = (int)(id % RFL); int oc = (int)(id / RFL); int c = oc & 255, o = oc >> 8; int y = idx - 129;
    float v = 0.f;
    if (y >= 0 && y <= L - 1) v = HF[((size_t)(o * 2 + 0) * L + (L - 1 - y)) * 256 + c];
    else if (y >= L && y <= 2 * L - 2) v = HF[((size_t)(o * 2 + 1) * L + (y - L + 1)) * 256 + c];
    stp(RFs + id, v);
}
__device__ __forceinline__ void d_k_hy_conv_cm(const pt* z  , int zc, const pt* gate, int gc, const pt* RFo  , const float* invn, const float* bias, pt* out, int oc_, size_t id_) {
    size_t id = (size_t)id_; int t = (int)(id % L); int bc = (int)(id / L); int c = bc & 255, b = bc >> 8;
    const pt* zr = z + ((size_t)b * zc + c) * L; const pt* rf = RFo + (size_t)c * RFL + 129 + (L - 1 - t);
    float a = 0.f;
    for (int s = 0; s < L; ++s) a += ldp(rf + s) * ldp(zr + s);
    stp(out + ((size_t)b * oc_ + c) * L + t, ldp(gate + ((size_t)b * gc + c) * L + t) * (a * invn[c] + ldp(zr + t) * bias[c]));
}
__device__ __forceinline__ void d_k_hy_tr(const pt* yt, pt* mixin, size_t id_) {
    size_t id = (size_t)id_; int c = id & 255; size_t row = id >> 8; size_t b = row / L; int t = (int)(row % L);
    mixin[row * DM + 768 + c] = yt[(b * 256 + c) * L + t];
}

constexpr int NSLOT = (2 * T + 16 * 255) / 256 * 256 + 256;
__device__ __forceinline__ void moe_tables(const int* CNT, int* pstart  ) {
    int acc = 0;
    for (int e = 0; e < 16; ++e) { pstart[e] = acc; acc += (CNT[e] + 255) / 256 * 256; }
    pstart[16] = acc;
}
__device__ __forceinline__ int moe_expert_of_row(const int* pstart, int row) { int e = 0; for (int i = 1; i < 16; ++i) if (row >= pstart[i]) e = i; return e; }
__device__ __forceinline__ void d_k_moe_hid2(const pt* XS, const int* CNT, const float* wg, const float* wu, pt* hid, size_t id_) {
    int ps[17]; moe_tables(CNT, ps);
    size_t id = (size_t)id_; int j = id & 511; int r = (int)(id >> 9); if (r >= ps[16]) return;
    int e = moe_expert_of_row(ps, r);
    const pt* x = XS + (size_t)r * DM; const float* g = wg + (size_t)e * DM * 512 + j; const float* u = wu + (size_t)e * DM * 512 + j;
    float sg = 0.f, su = 0.f;
    for (int i = 0; i < DM; ++i) { float xi = ldp(x + i); sg += xi * g[(size_t)i * 512]; su += xi * u[(size_t)i * 512]; }
    stp(hid + id, siluf_(sg) * su);
}
__device__ __forceinline__ void d_k_moe_down2(const pt* hid, const int* CNT, const float* wd, pt* y, size_t id_) {
    int ps[17]; moe_tables(CNT, ps);
    size_t id = (size_t)id_; int n = id & 1023; int r = (int)(id >> 10); if (r >= ps[16]) return;
    int e = moe_expert_of_row(ps, r);
    const pt* hrow = hid + (size_t)r * 512; const float* w = wd + (size_t)e * 512 * DM + n;
    float sacc = 0.f; for (int j = 0; j < 512; ++j) sacc += ldp(hrow + j) * w[(size_t)j * DM];
    stp(y + id, sacc);
}
__device__ __forceinline__ void d_k_ln2(const float* a, const pt* Y, const int* SLOT, const float* W, float alpha, const float* g, const float* be, float* out, pt* xb, size_t id_) {
    int r = (int)id_;
    const float* ar = a + (size_t)r * DM; const pt* y0 = Y + (size_t)SLOT[2 * r] * DM; const pt* y1 = Y + (size_t)SLOT[2 * r + 1] * DM; const float w0 = W[2 * r], w1 = W[2 * r + 1];
    float s = 0.f;
    for (int i = 0; i < DM; ++i) s += alpha * ar[i] + (w0 * ldp(y0 + i) + w1 * ldp(y1 + i));
    float mean = s / DM, q = 0.f;
    for (int i = 0; i < DM; ++i) { float d = alpha * ar[i] + (w0 * ldp(y0 + i) + w1 * ldp(y1 + i)) - mean; q += d * d; }
    float rstd = 1.0f / sqrtf(q / DM + LN_EPS);
    float* o = out + (size_t)r * DM; pt* ob = xb + (size_t)r * DM;
    for (int i = 0; i < DM; ++i) { float v = alpha * ar[i] + (w0 * ldp(y0 + i) + w1 * ldp(y1 + i)); float yy = (v - mean) * rstd * g[i] + be[i]; o[i] = yy; stp(ob + i, yy); }
}
__device__ __forceinline__ void d_k_moe_assign(const int* E, const int* CNT, int* CUR, int* SLOT, size_t id_) {
    int t = (int)id_; int ps[17]; moe_tables(CNT, ps);
#pragma unroll
    for (int k = 0; k < 2; ++k) { int e = E[2 * t + k]; int base = 0;
#pragma unroll
        for (int i = 0; i < 16; ++i) if (i == e) base = ps[i];
        SLOT[2 * t + k] = base + atomicAdd(CUR + e, 1); }
}
__device__ __forceinline__ void d_k_moe_gather(const pt* XB, const int* SLOT, pt* XS, size_t id_) {
    size_t id = (size_t)id_; int i = id & 1023; int a = (int)(id >> 10); int t = a >> 1;
    XS[(size_t)SLOT[a] * DM + i] = XB[(size_t)t * DM + i];
}

static inline constexpr size_t al256c(size_t x) { return (x + 255) & ~(size_t)255; }
constexpr size_t MiB = (size_t)1 << 20;
constexpr size_t OFF_WIN = 0, OFF_WO = OFF_WIN + (size_t)NP * DM * 2, OFF_WGU = OFF_WO + (size_t)DM * DM * 2, OFF_WD = OFF_WGU + (size_t)16 * 1024 * 1024 * 2, OFF_WEND = OFF_WD + (size_t)16 * 1024 * 512 * 2;
#if defined(CPU_EMU)
constexpr size_t OFF_HA = al256c(OFF_WEND);
constexpr size_t OFF_HB = al256c(OFF_HA + (size_t)L * 64 * 4);
constexpr size_t OFF_INVN = al256c(OFF_HB + (size_t)L * 64 * 4);
#else
constexpr size_t OFF_HA = 0, OFF_HB = 0;
constexpr size_t OFF_INVN = al256c(OFF_WEND);
#endif
constexpr size_t OFF_LB = al256c(OFF_INVN + 1024 * 4);
constexpr size_t OFF_RE = al256c(OFF_LB + 2 * 768 * 4);
constexpr size_t OFF_RW = al256c(OFF_RE + (size_t)T * 2 * 4);
constexpr size_t OFF_SLOT = al256c(OFF_RW + (size_t)T * 2 * 4);
constexpr size_t OFF_CNT = al256c(OFF_SLOT + (size_t)T * 2 * 4);
constexpr size_t OFF_BAR = al256c(OFF_CNT + 256);
constexpr size_t OFF_DDG = al256c(OFF_BAR + 3456 * 4);
constexpr size_t OFF_DDH = al256c(OFF_DDG + (size_t)NB * 12 * (L / 64) * 32 * 4);
constexpr size_t OFF_PROJ = al256c(OFF_DDH + (size_t)NB * 12 * (L / 64) * 64 * 4);
constexpr size_t OFF_XB = al256c(OFF_PROJ + (size_t)T * NP * sizeof(pt));
constexpr size_t OFF_U2 = al256c(OFF_XB + (size_t)T * DM * sizeof(pt));
constexpr size_t OFF_RF = al256c(OFF_U2 + (size_t)T * 768 * sizeof(pt));
constexpr size_t OFF_Z1 = al256c(OFF_RF + (size_t)1024 * RFL * sizeof(pt));
constexpr size_t OFF_YT = al256c(OFF_Z1 + (size_t)T * 256 * sizeof(pt));
constexpr size_t OFF_AL = al256c(OFF_Z1 + (size_t)NB * 12 * (L / 64) * 64 * 32 * 2);
#ifdef CPU_EMU
constexpr size_t OFF_HF = al256c(OFF_AL + (size_t)2 * T * 192 * sizeof(pt) + (size_t)T * 512 * sizeof(pt));
constexpr size_t WS_NEED = al256c(OFF_HF + (size_t)4 * L * 256 * 4);
constexpr size_t OFF_XS = WS_NEED;
#else
constexpr size_t OFF_HF = OFF_XB;
constexpr size_t WS_NEED = al256c(OFF_AL + (size_t)2 * T * 192 * sizeof(pt));
constexpr size_t OFF_XS = OFF_PROJ;
static_assert(OFF_AL >= OFF_YT + 0 && OFF_AL + (size_t)2 * T * 192 * 2 >= OFF_YT + (size_t)T * 256 * 2, "AL sits behind the GLA states and covers the tail of the span");
#endif
constexpr size_t OFF_DSH = OFF_U2, OFF_DSG = OFF_Z1;
constexpr size_t OFF_MIX = OFF_PROJ, OFF_Y = OFF_XS, OFF_HID = al256c(OFF_XS + (size_t)NSLOT * DM * sizeof(pt));
#ifndef CPU_EMU
static_assert(OFF_HID + (size_t)NSLOT * 512 * sizeof(pt) <= OFF_XB, "MoE overlay must stay inside PROJ");
static_assert((size_t)NB * 12 * (L / 64) * 64 * 64 * 2 <= (size_t)T * 768 * 2 && (size_t)NB * 12 * (L / 64) * 64 * 32 * 2 <= (size_t)T * 512 * 2, "scan state overlays");
static_assert(WS_NEED <= 512 * MiB, "workspace");
#endif
constexpr int NPL = 18, NPH = 1 + DEPTH * NPL;
constexpr int LDS_BYTES = 163840;

struct MP { const float* in[30]; float* out; char* ws; };

#ifndef CPU_EMU
__device__ __forceinline__ int make_tid(int wv) { int t; asm volatile("v_mbcnt_lo_u32_b32 %0, -1, 0\n\tv_mbcnt_hi_u32_b32 %0, -1, %0" : "=v"(t)); return (wv << 6) | t; }
#define opaque_tid() make_tid(wv_)
namespace pg8 {
#define PG8_LAS __attribute__((address_space(3)))
typedef unsigned short bf16_t;
typedef short bf16x8 __attribute__((ext_vector_type(8)));
typedef float f32x4 __attribute__((ext_vector_type(4)));
typedef unsigned u32x4 __attribute__((ext_vector_type(4)));
constexpr int BM = 256, BK = 64, HALF = 128, HTB = HALF * BK * 2  , STAGE_BYTES = 8 * HTB, NXCD = 8, WGM = 8;

__host__ __device__ __forceinline__ int lds_byte(int r, int c) { const int st = (r >> 4) * 2 + (c >> 5), rr = r & 15, cc = c & 31, ob = rr * 64 + cc * 2; return st * 1024 + (ob ^ (((ob >> 9) & 1) << 5)); }
__host__ __device__ __forceinline__ void stage_rc(int b, int& R, int& C) { const int st = b / 1024, sb = b % 1024, swz = sb ^ (((sb >> 9) & 1) << 5); R = (st >> 1) * 16 + swz / 64; C = (st & 1) * 32 + (swz % 64) / 2; }
__host__ __device__ __forceinline__ int perm32(int rho) { const int n = rho >> 4, i = rho & 15; return 8 * (i >> 2) + 4 * n + (i & 3); }

struct Unit { int pm, pn; const char* a; const char* b; const int* rows; };
struct Gemm { const bf16_t* A; const bf16_t* Bt; int M, N, K, lda; };
__device__ __forceinline__ unsigned cvt_pk_bf16(float lo, float hi) { unsigned r; asm volatile("v_cvt_pk_bf16_f32 %0, %1, %2" : "=v"(r) : "v"(lo), "v"(hi)); return r; }
template <class Epi, class Sched, bool ALIGN_EPI = false, bool SP2 = false, bool GATHER = false>
__device__ __forceinline__ void gemm_phase(PG8_LAS unsigned char* lds, const Gemm g, const Sched& S, const Epi& E, int wv_) {
    const int tid = opaque_tid(), wid = __builtin_amdgcn_readfirstlane(tid >> 6), lane = tid & 63, wr = wid >> 2, wc = wid & 3, fr = lane & 15, fq = lane >> 4;
    const int K = g.K, nt = K / BK;
    unsigned voffA[2], voffB[2];
#pragma unroll
    for (int i = 0; i < 2; ++i) { int R, C; stage_rc(tid * 16 + i * 8192, R, C); const int Rb = Epi::PERM ? ((R & ~31) + perm32(R & 31)) : R;
        voffA[i] = (unsigned)(R * g.lda + C) * 2u; voffB[i] = (unsigned)(Rb * K + C) * 2u; }
    const size_t kstep = (size_t)(BK * 2);
    const size_t hstepA = GATHER ? (size_t)0 : (size_t)HALF * g.lda * 2, hstepB = (size_t)HALF * K * 2;
    unsigned oc[2][2] = {{0u, 0u}, {0u, 0u}};
#define PG8_GOFF(dst, rows_) do { _Pragma("unroll") for (int i_ = 0; i_ < 2; ++i_) { int R_, C_; stage_rc(opaque_tid() * 16 + i_ * 8192, R_, C_); _Pragma("unroll") for (int h_ = 0; h_ < 2; ++h_) \
        dst[h_][i_] = (unsigned)*(const int*)((const char*)(rows_) + ((unsigned)R_ * 4u + 512u * h_)) * (unsigned)(g.lda * 2) + (unsigned)C_ * 2u; } } while (0)
    const unsigned ldsw = (unsigned)wid * 1024u;
    const int aoff = lds_byte(wr * 64 + fr, fq * 8), boff = lds_byte(wc * 32 + fr, fq * 8);
#define PG8_SA(b, h) (((b) * 2 + (h)) * HTB)
#define PG8_SB(b, h) ((4 + (b) * 2 + (h)) * HTB)
#define PG8_STAGE(bufoff, gbase, voff) do { _Pragma("unroll") for (int _i = 0; _i < 2; ++_i) \
        __builtin_amdgcn_global_load_lds((const unsigned*)((const char*)(gbase) + (voff)[_i]), (PG8_LAS unsigned*)(lds + (bufoff) + ldsw + _i * 8192), 16, 0, 0); } while (0)
#define PG8_LDA(dst, b, h) do { _Pragma("unroll") for (int m = 0; m < 4; ++m) _Pragma("unroll") for (int k = 0; k < 2; ++k) dst[m][k] = *(const PG8_LAS bf16x8*)(lds + PG8_SA(b, h) + aoff + m * 2048 + k * 1024); } while (0)
#define PG8_LDB(dst, b, h) do { _Pragma("unroll") for (int n = 0; n < 2; ++n) _Pragma("unroll") for (int k = 0; k < 2; ++k) dst[n][k] = *(const PG8_LAS bf16x8*)(lds + PG8_SB(b, h) + boff + n * 2048 + k * 1024); } while (0)
#define PG8_MMA(ai, bj, At, Bt) do { __builtin_amdgcn_s_setprio(1); _Pragma("unroll") for (int m = 0; m < 4; ++m) _Pragma("unroll") for (int n = 0; n < 2; ++n) _Pragma("unroll") for (int k = 0; k < 2; ++k) \
        acc[ai][bj][m][n] = __builtin_amdgcn_mfma_f32_16x16x32_bf16(Bt[n][k], At[m][k], acc[ai][bj][m][n], 0, 0, 0); __builtin_amdgcn_s_setprio(0); } while (0)
#define PG8_WAIT_V(n) asm volatile("s_waitcnt vmcnt(" #n ")" ::: "memory")
#define PG8_WAIT_L(n) asm volatile("s_waitcnt lgkmcnt(" #n ")" ::: "memory")
#define PG8_BAR __builtin_amdgcn_s_barrier()
#define PG8_SCHED __builtin_amdgcn_sched_barrier(0)
    Unit cur, nxt; int ui = 0;
    if (!S.next(0, cur)) return;
    f32x4 acc[2][2][4][2];
#pragma unroll
    for (int a = 0; a < 2; ++a)
#pragma unroll
        for (int b = 0; b < 2; ++b)
#pragma unroll
            for (int m = 0; m < 4; ++m)
#pragma unroll
                for (int n = 0; n < 2; ++n) acc[a][b][m][n] = (f32x4){0.f, 0.f, 0.f, 0.f};
    bf16x8 At[4][2], B0[2][2], B1[2][2];
    const char* cA = cur.a; const char* cB = cur.b;
    if constexpr (GATHER) PG8_GOFF(oc, cur.rows);
    S.a_ready(cur);
    if constexpr (SP2) {
        PG8_STAGE(PG8_SB(0, 0), cB, voffB); PG8_STAGE(PG8_SB(0, 1), cB + hstepB, voffB); PG8_STAGE(PG8_SA(0, 0), cA, (GATHER ? oc[0] : voffA)); PG8_STAGE(PG8_SA(0, 1), cA + hstepA, (GATHER ? oc[1] : voffA));
        if (wr == 1) PG8_BAR;
        PG8_WAIT_V(2); PG8_BAR;
        PG8_STAGE(PG8_SB(1, 0), cB + kstep, voffB); PG8_STAGE(PG8_SA(1, 0), cA + kstep, (GATHER ? oc[0] : voffA)); PG8_STAGE(PG8_SB(1, 1), cB + hstepB + kstep, voffB);
        PG8_WAIT_V(6); PG8_BAR;
    } else {
        PG8_STAGE(PG8_SB(0, 0), cB, voffB); PG8_STAGE(PG8_SA(0, 0), cA, voffA); PG8_STAGE(PG8_SB(0, 1), cB + hstepB, voffB); PG8_STAGE(PG8_SA(0, 1), cA + hstepA, voffA);
        if (wr == 1) PG8_BAR;
        PG8_WAIT_V(4); PG8_BAR;
        PG8_STAGE(PG8_SB(1, 0), cB + kstep, voffB); PG8_STAGE(PG8_SA(1, 0), cA + kstep, voffA); PG8_STAGE(PG8_SB(1, 1), cB + hstepB + kstep, voffB);
        PG8_WAIT_V(6); PG8_BAR;
    }
    for (;;) {
        const bool has_next = S.next(ui + 1, nxt);
        if constexpr (GATHER) { if (has_next) { unsigned on[2][2]; PG8_GOFF(on, nxt.rows); *(PG8_LAS u32x4*)(lds + STAGE_BYTES + tid * 16) = (u32x4){on[0][0], on[0][1], on[1][0], on[1][1]}; } }
        const char* nA = has_next ? nxt.a : cA; const char* nB = has_next ? nxt.b : cB;
        for (int t = 0; t < nt; t += 2) {
            const bool last = (t == nt - 2);
            const char* a1 = cA + (size_t)(t + 1) * kstep;
            const char* a2 = last ? nA : cA + (size_t)(t + 2) * kstep; const char* b2 = last ? nB : cB + (size_t)(t + 2) * kstep;
            const char* a3 = a2 + kstep; const char* b3 = b2 + kstep;
            if (last && has_next) S.a_ready(nxt);
            unsigned sx0[2], sx1[2];
            if constexpr (GATHER) { sx0[0] = oc[0][0]; sx0[1] = oc[0][1]; sx1[0] = oc[1][0]; sx1[1] = oc[1][1];
                if (last && has_next) { const u32x4 nv = *(const PG8_LAS u32x4*)(lds + STAGE_BYTES + tid * 16); sx0[0] = nv[0]; sx0[1] = nv[1]; sx1[0] = nv[2]; sx1[1] = nv[3]; } }
            else { sx0[0] = voffA[0]; sx0[1] = voffA[1]; sx1[0] = voffA[0]; sx1[1] = voffA[1]; }
            if constexpr (SP2) {
            PG8_LDB(B0, 0, 0); PG8_LDB(B1, 0, 1); PG8_SCHED; PG8_LDA(At, 0, 0); PG8_STAGE(PG8_SA(1, 1), a1 + hstepA, (GATHER ? oc[1] : voffA));
            PG8_WAIT_V(8); PG8_WAIT_L(0); PG8_BAR; PG8_MMA(0, 0, At, B0); PG8_MMA(0, 1, At, B1); PG8_BAR; PG8_SCHED;
            PG8_LDA(At, 0, 1); PG8_STAGE(PG8_SB(0, 0), b2, voffB); PG8_STAGE(PG8_SB(0, 1), b2 + hstepB, voffB); PG8_STAGE(PG8_SA(0, 0), a2, sx0);
            PG8_WAIT_V(8); PG8_WAIT_L(0); PG8_BAR; PG8_MMA(1, 0, At, B0); PG8_MMA(1, 1, At, B1); PG8_BAR; PG8_SCHED;
            PG8_LDB(B0, 1, 0); PG8_LDB(B1, 1, 1); PG8_SCHED; PG8_LDA(At, 1, 0); PG8_STAGE(PG8_SA(0, 1), a2 + hstepA, sx1);
            PG8_WAIT_V(8); PG8_WAIT_L(0); PG8_BAR; PG8_MMA(0, 0, At, B0); PG8_MMA(0, 1, At, B1); PG8_BAR; PG8_SCHED;
            PG8_LDA(At, 1, 1); PG8_STAGE(PG8_SB(1, 0), b3, voffB); PG8_STAGE(PG8_SB(1, 1), b3 + hstepB, voffB); PG8_STAGE(PG8_SA(1, 0), a3, sx0);
            PG8_WAIT_V(8); PG8_WAIT_L(0); PG8_BAR; PG8_MMA(1, 0, At, B0); PG8_MMA(1, 1, At, B1); PG8_BAR; PG8_SCHED;
            } else {
            PG8_LDB(B0, 0, 0); PG8_SCHED; PG8_LDA(At, 0, 0); PG8_STAGE(PG8_SA(1, 1), a1 + hstepA, voffA);
            PG8_WAIT_L(8); PG8_BAR; PG8_WAIT_L(0); PG8_MMA(0, 0, At, B0); PG8_BAR; PG8_SCHED;
            PG8_LDB(B1, 0, 1); PG8_STAGE(PG8_SB(0, 0), b2, voffB);
            PG8_BAR; PG8_WAIT_L(0); PG8_MMA(0, 1, At, B1); PG8_BAR;
            PG8_LDA(At, 0, 1); PG8_STAGE(PG8_SA(0, 0), a2, voffA);
            PG8_BAR; PG8_WAIT_L(0); PG8_MMA(1, 0, At, B0); PG8_BAR; PG8_SCHED;
            PG8_STAGE(PG8_SB(0, 1), b2 + hstepB, voffB);
            PG8_WAIT_V(6); PG8_BAR; PG8_MMA(1, 1, At, B1); PG8_BAR;
            PG8_LDB(B0, 1, 0); PG8_SCHED; PG8_LDA(At, 1, 0); PG8_STAGE(PG8_SA(0, 1), a2 + hstepA, voffA);
            PG8_WAIT_L(8); PG8_BAR; PG8_WAIT_L(0); PG8_MMA(0, 0, At, B0); PG8_BAR; PG8_SCHED;
            PG8_LDB(B1, 1, 1); PG8_STAGE(PG8_SB(1, 0), b3, voffB);
            PG8_BAR; PG8_WAIT_L(0); PG8_MMA(0, 1, At, B1); PG8_BAR;
            PG8_LDA(At, 1, 1); PG8_STAGE(PG8_SA(1, 0), a3, voffA);
            PG8_BAR; PG8_WAIT_L(0); PG8_MMA(1, 0, At, B0); PG8_BAR; PG8_SCHED;
            PG8_STAGE(PG8_SB(1, 1), b3 + hstepB, voffB);
            PG8_WAIT_V(6); PG8_BAR; PG8_MMA(1, 1, At, B1); PG8_BAR;
            }
        }
        if constexpr (ALIGN_EPI) { if (wr == 0) PG8_BAR; }
        if constexpr (!Epi::AFTER_DRAIN) { E(acc, cur, wr, wc, fr, fq); S.done(cur); }
        if (!has_next) break;
#pragma unroll
        for (int a = 0; a < 2; ++a)
#pragma unroll
            for (int b = 0; b < 2; ++b)
#pragma unroll
                for (int m = 0; m < 4; ++m)
#pragma unroll
                    for (int n = 0; n < 2; ++n) acc[a][b][m][n] = (f32x4){0.f, 0.f, 0.f, 0.f};
        cur = nxt; cA = nA; cB = nB; ++ui;
        if constexpr (GATHER) { const u32x4 nv = *(const PG8_LAS u32x4*)(lds + STAGE_BYTES + tid * 16); oc[0][0] = nv[0]; oc[0][1] = nv[1]; oc[1][0] = nv[2]; oc[1][1] = nv[3]; }
        if constexpr (ALIGN_EPI) { if (wr == 1) PG8_BAR; }
    }
    PG8_WAIT_V(0);
    if constexpr (!ALIGN_EPI) { if (wr == 0) PG8_BAR; }
    PG8_BAR;
    if constexpr (Epi::AFTER_DRAIN) { E.fused(acc, cur, wr, wc, fr, fq, lds, wid, lane); S.done(cur); }
#undef PG8_GOFF
#undef PG8_SA
#undef PG8_SB
#undef PG8_STAGE
#undef PG8_LDA
#undef PG8_LDB
#undef PG8_MMA
#undef PG8_WAIT_V
#undef PG8_WAIT_L
#undef PG8_BAR
#undef PG8_SCHED
}
}

typedef float cv_f32x2 __attribute__((ext_vector_type(2))); typedef __bf16 cv_bf16x2 __attribute__((ext_vector_type(2)));
__device__ __forceinline__ unsigned cvtpk(float lo, float hi) { const cv_f32x2 v = {lo, hi}; const cv_bf16x2 b2 = __builtin_convertvector(v, cv_bf16x2); return __builtin_bit_cast(unsigned, b2); }
__device__ __forceinline__ float rdlane(float v, int k) { return __int_as_float(__builtin_amdgcn_readlane(__float_as_int(v), k)); }
template <int CTRL> __device__ __forceinline__ float dppf(float v) { return __int_as_float(__builtin_amdgcn_update_dpp(0, __float_as_int(v), CTRL, 0xf, 0xf, false)); }
__device__ __forceinline__ float rowsum16(float v) { v += dppf<0xB1>(v); v += dppf<0x4E>(v); v += dppf<0x141>(v); v += dppf<0x140>(v); return v; }
#define LAS __attribute__((address_space(3)))
#define LDS_BARRIER() do { asm volatile("s_waitcnt lgkmcnt(0)" ::: "memory"); __builtin_amdgcn_s_barrier(); asm volatile("" ::: "memory"); } while (0)
typedef unsigned v4u __attribute__((ext_vector_type(4)));
typedef float f32x4 __attribute__((ext_vector_type(4)));

#define XB_TMO      128
#define XB_XCNT(j)  (256  + 64 * (j))
#define XB_XSUB(j)  (1280 + 64 * (j))
#define XB_XGEN(j)  (2304 + 64 * (j))
#define XB_TOP      3328
#define XB_TOPGEN   3392
#define XCD_BAR_WORDS 3456
#define XB_SPIN_CAP (1u << 18)
__device__ __forceinline__ unsigned xb_ld(unsigned* p)              { return __hip_atomic_load(p, __ATOMIC_RELAXED, __HIP_MEMORY_SCOPE_AGENT); }
__device__ __forceinline__ unsigned xb_add(unsigned* p, unsigned v) { return __hip_atomic_fetch_add(p, v, __ATOMIC_RELAXED, __HIP_MEMORY_SCOPE_AGENT); }
__device__ __forceinline__ unsigned xb_xcc_id() { return (unsigned)__builtin_amdgcn_s_getreg((3 << 11) | 20) & 0xFu; }
#define XB_SPIN(cond, bar) do { unsigned _sp = 0; while (cond) { __builtin_amdgcn_s_sleep(1); \
    if ((++_sp & 255u) == 0u) { if (xb_ld(&(bar)[XB_TMO])) break; if (_sp > XB_SPIN_CAP) { atomicAdd(&(bar)[XB_TMO], 1u); break; } } } } while (0)
struct XcdBarrier { unsigned* bar; unsigned x; volatile LAS unsigned* st; };
__device__ __forceinline__ XcdBarrier xcd_barrier_post(unsigned* bar, volatile LAS unsigned* st, bool t0) {
    XcdBarrier b; b.bar = bar; b.x = xb_xcc_id(); b.st = st;
    if (t0) (void)xb_add(&bar[XB_XCNT(b.x)], 1u);
    return b;
}
__device__ __forceinline__ void xcd_barrier_complete(unsigned* bar, unsigned x, unsigned& nloc, unsigned& nx) {
    const unsigned G = gridDim.x * gridDim.y * gridDim.z;
    unsigned sum, cnt, mine, sp = 0u;
    for (;;) {
        sum = 0u; cnt = 0u; mine = 0u;
#pragma unroll
        for (unsigned j = 0; j < 16; ++j) { const unsigned c = xb_ld(&bar[XB_XCNT(j)]); sum += c; cnt += (c > 0u) ? 1u : 0u; mine = (j == x) ? c : mine; }
        if (sum == G) break;
        __builtin_amdgcn_s_sleep(1);
        if ((++sp & 255u) == 0u) { if (xb_ld(&bar[XB_TMO])) break; if (sp > XB_SPIN_CAP) { atomicAdd(&bar[XB_TMO], 1u); break; } }
    }
    nloc = mine > 0u ? mine : 1u; nx = cnt > 0u ? cnt : 1u;
}
__device__ __forceinline__ void xcd_barrier(const XcdBarrier& b, int wv_) {
    asm volatile("s_waitcnt vmcnt(0)" ::: "memory");
    __syncthreads();
    if (make_tid(wv_) == 0) {
        unsigned* bar = b.bar; asm volatile("" : "+s"(bar)); const unsigned bx = xb_xcc_id();
        __builtin_amdgcn_s_waitcnt(0);
        unsigned nloc = b.st[0], nx = b.st[1];
        if (nloc == 0u) { xcd_barrier_complete(bar, bx, nloc, nx); b.st[0] = nloc; b.st[1] = nx; }
        const unsigned old = xb_add(&bar[XB_XSUB(bx)], 1u);
        const unsigned gen = old / nloc;
        if (old + 1u == (gen + 1u) * nloc) {
            __builtin_amdgcn_fence(__ATOMIC_RELEASE, "agent");
            asm volatile("s_waitcnt vmcnt(0)" ::: "memory");
            const unsigned og = xb_add(&bar[XB_TOP], 1u);
            const unsigned tg = og / nx;
            if (og + 1u == (tg + 1u) * nx) xb_add(&bar[XB_TOPGEN], 1u);
            else XB_SPIN(xb_ld(&bar[XB_TOPGEN]) == tg, bar);
            __builtin_amdgcn_fence(__ATOMIC_ACQUIRE, "agent");
            xb_add(&bar[XB_XGEN(bx)], 1u);
            asm volatile("s_waitcnt vmcnt(0)" ::: "memory");
        } else {
            XB_SPIN(xb_ld(&bar[XB_XGEN(bx)]) == gen, bar);
            __builtin_amdgcn_fence(__ATOMIC_ACQUIRE, "agent");
            asm volatile("s_waitcnt vmcnt(0)" ::: "memory");
        }
    }
    __syncthreads();
}
struct SchedStatic {
    const char* A; const char* B; int nM, nN, nwg, G, c; size_t tstepA, tstepB;
    __device__ void init(const void* A_, const void* B_, int M, int N, int K, int G_, int c_, int lda = 0) { A = (const char*)A_; B = (const char*)B_; nM = M / 256; nN = N / 256; nwg = nM * nN; G = G_; c = c_; tstepB = (size_t)256 * K * 2; tstepA = (size_t)256 * (lda ? lda : K) * 2; }
    __device__ bool next(int i, pg8::Unit& u) const {
        const long Lx = (long)i * G + c; if (Lx >= nwg) return false;
        int wgid = (int)Lx; { const int q = nwg / 8, r = nwg % 8, xcd = wgid % 8, off = wgid / 8; wgid = (xcd < r ? xcd * (q + 1) : r * (q + 1) + (xcd - r) * q) + off; }
        const int nig = 8 * nN, gid = wgid / nig, fm = gid * 8, gsz = (nM - fm) < 8 ? (nM - fm) : 8;
        u.pm = fm + ((wgid % nig) % gsz); u.pn = (wgid % nig) / gsz; u.a = A + (size_t)u.pm * tstepA; u.b = B + (size_t)u.pn * tstepB; u.rows = nullptr; return true;
    }
    __device__ __forceinline__ void a_ready(const pg8::Unit&) const {}
    __device__ __forceinline__ void done(const pg8::Unit&) const {}
};
struct EpiBf16Store {
    static constexpr bool PERM = true, AFTER_DRAIN = false;
    pt* O; int ldc;
    __device__ __forceinline__ void operator()(const f32x4 (&acc)[2][2][4][2], const pg8::Unit& u, int wr, int wc, int fr, int fq) const {
        const int row0 = u.pm * 256 + wr * 64 + fr, col0 = u.pn * 256 + wc * 32 + 8 * fq;
#pragma unroll
        for (int ai = 0; ai < 2; ++ai)
#pragma unroll
            for (int m = 0; m < 4; ++m) { pt* rowp = O + (size_t)(row0 + ai * 128 + m * 16) * ldc + col0;
#pragma unroll
                for (int bj = 0; bj < 2; ++bj) { const f32x4 v0 = acc[ai][bj][m][0], v1 = acc[ai][bj][m][1]; v4u w;
                    w.x = cvtpk(v0[0], v0[1]); w.y = cvtpk(v0[2], v0[3]); w.z = cvtpk(v1[0], v1[1]); w.w = cvtpk(v1[2], v1[3]);
                    *(v4u*)(rowp + bj * 128) = w; } }
    }
};

struct EpiProjAct {
    static constexpr bool PERM = true, AFTER_DRAIN = false;
    pt* O; int ldc; const float* lb;
    __device__ __forceinline__ void operator()(const f32x4 (&acc)[2][2][4][2], const pg8::Unit& u, int wr, int wc, int fr, int fq) const {
        const int row0 = u.pm * 256 + wr * 64 + fr, col0 = u.pn * 256 + wc * 32 + 8 * fq;
#pragma unroll
        for (int bj = 0; bj < 2; ++bj) { const int cs = u.pn * 256 + bj * 128;
            const int kind = (cs >= C_GG && cs < C_HF) ? 1 : (cs >= C_HF && cs < C_HGT) ? 3 : (cs >= C_HGT && cs < C_GA) ? 2 : 0;
            f32x4 l0 = {0.f, 0.f, 0.f, 0.f}, l1 = {0.f, 0.f, 0.f, 0.f};
            if (kind == 3) { const f32x4 t0_ = *(const f32x4*)(lb + (col0 + bj * 128 - C_HF)), t1_ = *(const f32x4*)(lb + (col0 + bj * 128 - C_HF) + 4);
#pragma unroll
                for (int i = 0; i < 4; ++i) { asm volatile("v_mov_b32 %0, %1" : "=v"(l0[i]) : "v"(t0_[i])); asm volatile("v_mov_b32 %0, %1" : "=v"(l1[i]) : "v"(t1_[i])); } }
#pragma unroll
            for (int ai = 0; ai < 2; ++ai)
#pragma unroll
                for (int m = 0; m < 4; ++m) { pt* rowp = O + (size_t)(row0 + ai * 128 + m * 16) * ldc + col0 + bj * 128; float v[8];
#pragma unroll
                    for (int i = 0; i < 8; ++i) { const float x = acc[ai][bj][m][i >> 2][i & 3]; float y = x;
                        if (kind == 1 || kind == 2) { const float sg = __builtin_amdgcn_rcpf(1.0f + __expf(-x)); y = kind == 1 ? x * sg : sg; }
                        else if (kind == 3) {
                            const float t = __expf(-fabsf(x)), lbv = i < 4 ? l0[i & 3] : l1[i & 3], sx = x >= 0.f ? 1.0f : t, num = lbv * (1.0f + t) + (1.0f - lbv) * sx;
                            const float lg = __logf(num * __builtin_amdgcn_rcpf(1.0f + t)); y = (lbv == 0.f && x < -80.f) ? x : lg; }
                        v[i] = y; }
                    v4u w; w.x = cvtpk(v[0], v[1]); w.y = cvtpk(v[2], v[3]); w.z = cvtpk(v[4], v[5]); w.w = cvtpk(v[6], v[7]); if (col0 + bj * 128 < DIN) *(v4u*)rowp = w; } }
    }
};
struct EpiF32Store {
    static constexpr bool PERM = false, AFTER_DRAIN = false;
    float* C; int ldc;
    __device__ __forceinline__ void operator()(const f32x4 (&acc)[2][2][4][2], const pg8::Unit& u, int wr, int wc, int fr, int fq) const {
        const int row0 = u.pm * 256 + wr * 64 + fr, col0 = u.pn * 256 + wc * 32 + 4 * fq;
#pragma unroll
        for (int ai = 0; ai < 2; ++ai)
#pragma unroll
            for (int m = 0; m < 4; ++m) { float* rowp = C + (size_t)(row0 + ai * 128 + m * 16) * ldc + col0;
#pragma unroll
                for (int bj = 0; bj < 2; ++bj)
#pragma unroll
                    for (int n = 0; n < 2; ++n) *(f32x4*)(rowp + bj * 128 + n * 16) = acc[ai][bj][m][n]; }
    }
};

struct SchedMoE {
    const char* A; const char* Bw; const int* rowtab; int te[16]; int ntiles, G, c; size_t tstepA, estepB, tstepB;
    __device__ __forceinline__ void init(const void* A_, const void* B_, int K, const int* CNT, size_t estepB_, int G_, int c_, const int* rowtab_ = nullptr) {
        A = (const char*)A_; Bw = (const char*)B_; G = G_; c = c_; tstepA = rowtab_ ? (size_t)0 : (size_t)256 * K * 2; tstepB = (size_t)256 * K * 2; estepB = estepB_; rowtab = rowtab_;
        int acc = 0;
#pragma unroll
        for (int e = 0; e < 16; ++e) { acc += (__builtin_amdgcn_readfirstlane(CNT[e]) + 255) >> 8; te[e] = acc; }
        ntiles = acc;
    }
    __device__ __forceinline__ bool next(int i, pg8::Unit& u) const {
        const int Lx = i * G + c; if (Lx >= ntiles * 4) return false;
        const int tile = Lx >> 2; int e = 0;
#pragma unroll
        for (int k = 0; k < 15; ++k) e += (tile >= te[k]) ? 1 : 0;
        u.pm = tile; u.pn = Lx & 3; u.a = A + (size_t)tile * tstepA; u.b = Bw + (size_t)e * estepB + (size_t)u.pn * tstepB; u.rows = rowtab + (size_t)tile * 256; return true;
    }
    __device__ __forceinline__ void a_ready(const pg8::Unit&) const {}
    __device__ __forceinline__ void done(const pg8::Unit&) const {}
};
struct EpiSiluMul {
    static constexpr bool PERM = true, AFTER_DRAIN = false;
    pt* O;
    __device__ __forceinline__ void operator()(const f32x4 (&acc)[2][2][4][2], const pg8::Unit& u, int wr, int wc, int fr, int fq) const {
        const int row0 = u.pm * 256 + wr * 64 + fr, col0 = u.pn * 128 + wc * 32 + 8 * fq;
#pragma unroll
        for (int ai = 0; ai < 2; ++ai)
#pragma unroll
            for (int m = 0; m < 4; ++m) { pt* rowp = O + (size_t)(row0 + ai * 128 + m * 16) * 512 + col0; float h[8];
#pragma unroll
                for (int n = 0; n < 2; ++n)
#pragma unroll
                    for (int i = 0; i < 4; ++i) { const float g = acc[ai][0][m][n][i], up = acc[ai][1][m][n][i]; h[n * 4 + i] = __fdividef(g, 1.0f + __expf(-g)) * up; }
                v4u w; w.x = cvtpk(h[0], h[1]); w.y = cvtpk(h[2], h[3]); w.z = cvtpk(h[4], h[5]); w.w = cvtpk(h[6], h[7]);
                *(v4u*)rowp = w; }
    }
};

typedef float f32x16 __attribute__((ext_vector_type(16)));
typedef short hbf16x8 __attribute__((ext_vector_type(8)));
typedef unsigned v2u __attribute__((ext_vector_type(2)));
constexpr int HY_ZPAD = 1024, HY_ZROW = SEQ_ + 2 * HY_ZPAD, HY_ZROWB = (HY_ZROW + 8 * (HY_ZROW / 128) + 64) * 2;
constexpr int HY_ZBYTES = 4 * HY_ZROWB, HY_RINGB = 512 * 2 + 64, HY_FWAVE = 8 * HY_RINGB, HY_LDS = HY_ZBYTES + 8 * HY_FWAVE;
static_assert(SEQ_ != 8192 || (HY_ZROWB % 256 == 128 && HY_LDS <= 163840), "hyena LDS map");
__device__ __forceinline__ int hy_zoff(int s) { const int p = s + HY_ZPAD; return (p + 8 * (p >> 7)) * 2; }
struct MoeCvt { const float* wg; long dgu; const float* wd; pt* WguT; pt* WdT; int it, step; };
constexpr int MC_IGU = 16 * 2 * 16 * 16, MC_NIT = MC_IGU + 16 * 8 * 32;
__device__ __forceinline__ void moe_item(const MoeCvt& m, int q, int lane, const float*& src, int& lsrc, pt*& dst) {
    const int n = lane & 31, ko = (lane >> 5) * 32 + (q & 1) * 16; int r = __builtin_amdgcn_readfirstlane(m.it + (q >> 1) * m.step);
    if (r < MC_IGU) { const int e = r / 512, hf = (r / 256) & 1, kb = (r / 16) & 15, nb = r & 15; lsrc = 512;
        src = (const float*)((const char*)m.wg + (long)hf * m.dgu) + (size_t)e * DM * 512 + (size_t)(kb * 64 + ko) * 512 + nb * 32 + n;
        dst = m.WguT + (size_t)e * 1024 * 1024 + (size_t)((nb >> 2) * 256 + hf * 128 + (nb & 3) * 32 + n) * 1024 + kb * 64 + ko; }
    else { r -= MC_IGU; const int e = r / 256, kb = (r / 32) & 7, nb = r & 31; lsrc = DM;
        src = m.wd + (size_t)e * 512 * DM + (size_t)(kb * 64 + ko) * DM + nb * 32 + n;
        dst = m.WdT + (size_t)e * 1024 * 512 + (size_t)(nb * 32 + n) * 512 + kb * 64 + ko; }
}
#define MC_VALID(m_, q_) ((m_).it + ((q_) >> 1) * (m_).step < MC_NIT)
#define MC_LOAD(m_, q_, cv_) do { const float* s_; int ls_; pt* d_; moe_item(m_, q_, lane, s_, ls_, d_); _Pragma("unroll") for (int i_ = 0; i_ < 16; ++i_) cv_[i_] = s_[(size_t)i_ * ls_]; } while (0)
#define MC_STORE(m_, q_, cv_) do { const float* s_; int ls_; pt* d_; moe_item(m_, q_, lane, s_, ls_, d_); _Pragma("unroll") for (int h_ = 0; h_ < 2; ++h_) { v4u o_; \
        o_.x = cvtpk(cv_[8 * h_], cv_[8 * h_ + 1]); o_.y = cvtpk(cv_[8 * h_ + 2], cv_[8 * h_ + 3]); o_.z = cvtpk(cv_[8 * h_ + 4], cv_[8 * h_ + 5]); o_.w = cvtpk(cv_[8 * h_ + 6], cv_[8 * h_ + 7]); \
        *(v4u*)(d_ + 8 * h_) = o_; } } while (0)
struct P2Side { pt* ds; const float* dd; int K, d; bool act; };
constexpr int P2_NT = NB * 12 * 1536, P2_NCH = SEQ_ / 64;
__device__ __forceinline__ P2Side p2_side_init(pt* DS_gla, float* DD_gla, pt* DS_hg, float* DD_hg, int wave_global, int nwaves, int lane) {
    const int per = (P2_NT + nwaves - 1) / nwaves; const size_t id = (size_t)wave_global * per + lane; P2Side r; r.act = lane < per && id < (size_t)P2_NT; const size_t idc = r.act ? id : 0;
    const bool hg = idc < (size_t)NB * 6 * 2 * 1024; const int K = hg ? 64 : 32; const size_t i2 = hg ? idc : idc - (size_t)NB * 6 * 2 * 1024;
    const int pe = 64 * K / 4; const int sd = (int)(i2 / pe), rem = (int)(i2 % pe), v = rem / (K / 4), kq = rem % (K / 4);
    r.K = K; r.d = sd & 1; r.ds = (hg ? DS_hg : DS_gla) + (size_t)sd * P2_NCH * 64 * K + (size_t)v * K + 4 * kq; r.dd = (hg ? DD_hg : DD_gla) + (size_t)sd * P2_NCH * K + 4 * kq; return r;
}
#define P2_LOAD(dv_, de_, tt_) do { _Pragma("unroll") for (int j_ = 0; j_ < 2; ++j_) { const int nn_ = 2 * (tt_) + j_; if (nn_ < P2_NCH && ps.act) { const int n_ = ps.d ? P2_NCH - 1 - nn_ : nn_; \
        dv_[j_] = *(const v2u*)(ps.ds + (size_t)n_ * 64 * ps.K); de_[j_] = *(const f32x4*)(ps.dd + (size_t)n_ * ps.K); } } } while (0)
#define P2_PROC(dv_, de_, tt_) do { _Pragma("unroll") for (int j_ = 0; j_ < 2; ++j_) { const int nn_ = 2 * (tt_) + j_; if (nn_ < P2_NCH && ps.act) { const int n_ = ps.d ? P2_NCH - 1 - nn_ : nn_; \
        v2u o_; o_.x = cvtpk(PS0, PS1); o_.y = cvtpk(PS2, PS3); *(v2u*)(ps.ds + (size_t)n_ * 64 * ps.K) = o_; \
        PS0 = de_[j_][0] * PS0 + __uint_as_float(dv_[j_].x << 16); PS1 = de_[j_][1] * PS1 + __uint_as_float(dv_[j_].x & 0xffff0000u); \
        PS2 = de_[j_][2] * PS2 + __uint_as_float(dv_[j_].y << 16); PS3 = de_[j_][3] * PS3 + __uint_as_float(dv_[j_].y & 0xffff0000u); } } } while (0)
#define P2_HOOK(dv_, de_) do { if (pt2 >= 2) P2_PROC(dv_, de_, pt2 - 2); P2_LOAD(dv_, de_, pt2); ++pt2; } while (0)
template <int SIDE = 0> __device__ __forceinline__ void hy_conv_mfma(LAS unsigned char* lds, const pt* zsrc, int zc, const pt* gate, int gc, const pt* RFo, const float* invn, const float* bias, pt* out, int oc_, int wv_, MoeCvt mc = MoeCvt(), P2Side ps = P2Side()) {
    const int tix = opaque_tid(), lane = tix & 63, w = __builtin_amdgcn_readfirstlane(tix >> 6), n = lane & 31, h = lane >> 5;
    const bool g1 = (n >= 4 && n < 12) || (n >= 16 && n < 20) || (n >= 28);
    const int rank = g1 ? (n < 12 ? n - 4 : (n < 20 ? n - 8 : n - 16)) : (n < 4 ? n : (n < 16 ? n - 8 : n - 12));
    const int b = (g1 ? 2 : 0) + (rank & 1), iota = rank >> 1;
    const int zlane = b * HY_ZROWB + 272 * iota + 16 * h;
    const int a = (7 - n) & 7, alane = 16 * h - 16 * (n >> 3) + 64, fwave = HY_ZBYTES + w * HY_FWAVE, fa = fwave + a * HY_RINGB;
    const int Yb = SEQ_ - 1025 - 1024 * w; int mq = 0;
    const int mqmax = SIDE == 1 ? (mc.it < MC_NIT ? 2 * ((MC_NIT - 1 - mc.it) / mc.step) + 1 : -1) : -1;
#define MCQ(q_) ((q_) < mqmax ? (q_) : (mqmax < 0 ? 0 : mqmax))
    int pt2 = 0; float PS0 = 0.f, PS1 = 0.f, PS2 = 0.f, PS3 = 0.f; v2u pdv0[2], pdv1[2]; f32x4 pde0[2], pde1[2];
#pragma unroll
    for (int j = 0; j < 2; ++j) { pdv0[j] = pdv1[j] = (v2u){0u, 0u}; pde0[j] = pde1[j] = (f32x4){0.f, 0.f, 0.f, 0.f}; }
    for (int c = blockIdx.x; c < 256; c += gridDim.x) {
        { const v4u zz = {0u, 0u, 0u, 0u}; for (int u = tix; u < HY_ZBYTES / 16; u += 512) *(LAS v4u*)(lds + u * 16) = zz; }
        __syncthreads();
        for (int u = tix; u < 4 * (SEQ_ / 8); u += 512) { const int bb = u / (SEQ_ / 8), s8 = (u % (SEQ_ / 8)) * 8;
            const v4u v = *(const v4u*)(zsrc + ((size_t)bb * zc + c) * SEQ_ + s8); *(LAS v4u*)(lds + bb * HY_ZROWB + hy_zoff(s8)) = v; }
        const pt* rf = RFo + (size_t)c * RFL;
#define HY_LOADCH(kc) (*(const unsigned*)(rf + (Yb + 128 * (kc) + 97 + 2 * lane)))
#define HY_WRITECH(kc, v) do { _Pragma("unroll") for (int a2 = 0; a2 < 8; ++a2) { const int rho = (128 * (kc) + 2 * lane + 7 - a2) & 511; LAS unsigned char* cp = lds + fwave + a2 * HY_RINGB; \
            if (a2 & 1) *(LAS unsigned*)(cp + 2 * rho) = (v); else { *(LAS unsigned short*)(cp + 2 * rho) = (unsigned short)((v) & 0xffffu); *(LAS unsigned short*)(cp + 2 * ((rho + 1) & 511)) = (unsigned short)((v) >> 16); } } } while (0)
        { const unsigned v0 = HY_LOADCH(0), v1 = HY_LOADCH(1); HY_WRITECH(0, v0); HY_WRITECH(1, v1); }
        __syncthreads();
        f32x16 acc[4];
#pragma unroll
        for (int q = 0; q < 4; ++q)
#pragma unroll
            for (int r = 0; r < 16; ++r) acc[q][r] = 0.f;
        hbf16x8 Bt[4][2];
#pragma unroll
        for (int q = 0; q < 4; ++q) { Bt[q][0] = *(const LAS hbf16x8*)(lds + zlane + 64 * q); Bt[q][1] = *(const LAS hbf16x8*)(lds + zlane + 64 * q + 32); }
        unsigned pq[6];
#pragma unroll
        for (int i = 0; i < 6; ++i) pq[i] = HY_LOADCH(2 + i);
        float cv[16];
#pragma unroll
        for (int i = 0; i < 16; ++i) cv[i] = 0.f;
        if constexpr (SIDE == 1) MC_LOAD(mc, MCQ(mq), cv);
#pragma unroll 1
        for (int k6 = 0; k6 < 72; k6 += 6) {
            if constexpr (SIDE == 1) { MC_STORE(mc, MCQ(mq), cv); MC_LOAD(mc, MCQ(mq + 1), cv); ++mq; }
#pragma unroll
            for (int ki = 0; ki < 6; ++ki) { const int k = k6 + ki;
#pragma unroll
                for (int j = 0; j < 4; ++j) {
                    const hbf16x8 A0 = *(const LAS hbf16x8*)(lds + fa + ((256 * k + 64 * j + alane) & 1023));
                    const hbf16x8 A1 = *(const LAS hbf16x8*)(lds + fa + ((256 * k + 64 * j + 32 + alane) & 1023));
                    const hbf16x8 Bn0 = *(const LAS hbf16x8*)(lds + zlane + 272 * (k + 1) + 64 * j);
                    const hbf16x8 Bn1 = *(const LAS hbf16x8*)(lds + zlane + 272 * (k + 1) + 64 * j + 32);
#pragma unroll
                    for (int q = 0; q < 4; ++q) acc[q] = __builtin_amdgcn_mfma_f32_32x32x16_bf16(A0, Bt[q][0], acc[q], 0, 0, 0);
#pragma unroll
                    for (int q = 0; q < 4; ++q) acc[q] = __builtin_amdgcn_mfma_f32_32x32x16_bf16(A1, Bt[q][1], acc[q], 0, 0, 0);
                    Bt[0][0] = Bt[1][0]; Bt[0][1] = Bt[1][1]; Bt[1][0] = Bt[2][0]; Bt[1][1] = Bt[2][1]; Bt[2][0] = Bt[3][0]; Bt[2][1] = Bt[3][1]; Bt[3][0] = Bn0; Bt[3][1] = Bn1;
                }
                const unsigned pv = pq[ki];
                HY_WRITECH(k + 2, pv);
                pq[ki] = HY_LOADCH(k + 8 < 74 ? k + 8 : 73);
                if constexpr (SIDE == 2) { if (ki & 1) P2_HOOK(pdv1, pde1); else P2_HOOK(pdv0, pde0); }
            }
        }

        const float sc = invn[c], bi = bias[c];
        v2u gva[4][4];
#pragma unroll
        for (int q = 0; q < 4; ++q)
#pragma unroll
            for (int rg = 0; rg < 4; ++rg) gva[q][rg] = *(const v2u*)(gate + ((size_t)b * gc + c) * SEQ_ + 32 * (32 * w + 4 * iota + q) + 8 * rg + 4 * h);
#pragma unroll
        for (int q = 0; q < 4; ++q)
#pragma unroll
            for (int rg = 0; rg < 4; ++rg) {
                const int t0 = 32 * (32 * w + 4 * iota + q) + 8 * rg + 4 * h;
                const v2u zv = *(const LAS v2u*)(lds + b * HY_ZROWB + hy_zoff(t0));
                const v2u gv = gva[q][rg];
                float o[4];
#pragma unroll
                for (int e = 0; e < 4; ++e) { const unsigned zw = e < 2 ? zv.x : zv.y, gw = e < 2 ? gv.x : gv.y; const float zf = __uint_as_float((e & 1) ? (zw & 0xffff0000u) : (zw << 16)), gf = __uint_as_float((e & 1) ? (gw & 0xffff0000u) : (gw << 16));
                    o[e] = gf * (acc[q][rg * 4 + e] * sc + zf * bi); }
                v2u ov; ov.x = f2bf(o[0]) | (f2bf(o[1]) << 16); ov.y = f2bf(o[2]) | (f2bf(o[3]) << 16);
                *(v2u*)(out + ((size_t)b * oc_ + c) * SEQ_ + t0) = ov;
            }
        __syncthreads();
    }
    if constexpr (SIDE == 2) { while (pt2 < P2_NCH / 2 + 2) { P2_HOOK(pdv0, pde0); P2_HOOK(pdv1, pde1); } }
    if constexpr (SIDE == 1) { for (; mq <= mqmax; ++mq) { float cv[16]; MC_LOAD(mc, mq, cv); MC_STORE(mc, mq, cv); } }
#undef HY_LOADCH
#undef HY_WRITECH
}
constexpr int SC_NCH = SEQ_ / 64, SC_HALF = 81920;
typedef short sbf16x8 __attribute__((ext_vector_type(8)));
typedef float f32x2 __attribute__((ext_vector_type(2)));
struct ScanP { const pt* proj; const float* wa2; const float* ba; const float* lb; pt* DS; float* DD; pt* mixin; const float* gain; pt* AL; int ms; };
struct GateCtx { float wa[2][16]; float c0[2]; };
__device__ __forceinline__ void sc_sig(float z, float& sg, float& omsg, float& e) { e = __expf(-fabsf(z)); const float inv = __fdividef(1.0f, 1.0f + e); const float a = inv, b2 = e * inv; sg = z >= 0.f ? a : b2; omsg = z >= 0.f ? b2 : a; }
template <int GRP> __device__ __forceinline__ void sc_ctx(const ScanP& A, int h, int k2, int d, GateCtx& c) {
    int off = (GRP ? h * 64 : h * 32) + k2; asm volatile("" : "+v"(off));
#pragma unroll
    for (int j = 0; j < 2; ++j) {
        if constexpr (GRP == 0) {
#pragma unroll
            for (int r = 0; r < 16; ++r) c.wa[j][r] = A.wa2[(d * 16 + r) * 192 + off + j];
            c.c0[j] = A.ba[d * 192 + off + j]; }
        else c.c0[j] = A.lb[d * 384 + off + j]; }
}
template <int GRP> struct GateRaw { v4u a0, a1; unsigned kw; };
template <> struct GateRaw<1> { unsigned kw; };
template <int GRP> __device__ __forceinline__ void sc_gate_load(const ScanP& A, size_t row, int h, int k2, int d, GateRaw<GRP>& R) {
    if constexpr (GRP == 0) { R.a0 = *(const v4u*)(A.proj + row * NPS + C_GA + 16 * d); R.a1 = *(const v4u*)(A.proj + row * NPS + C_GA + 16 * d + 8); R.kw = *(const unsigned*)(A.proj + row * NPS + C_GK + h * 32 + k2); }
    else R.kw = *(const unsigned*)(A.proj + row * NPS + C_HF + d * 384 + h * 64 + k2);
}
template <int GRP> __device__ __forceinline__ void sc_gate(const GateCtx& c, const GateRaw<GRP>& R, float (&g)[2], float (&kd)[2]) {
    if constexpr (GRP == 0) {
#pragma unroll
        for (int j = 0; j < 2; ++j) { float al = c.c0[j];
#pragma unroll
            for (int r = 0; r < 4; ++r) { al += __uint_as_float(R.a0[r] << 16) * c.wa[j][2 * r] + __uint_as_float(R.a0[r] & 0xffff0000u) * c.wa[j][2 * r + 1]; al += __uint_as_float(R.a1[r] << 16) * c.wa[j][8 + 2 * r] + __uint_as_float(R.a1[r] & 0xffff0000u) * c.wa[j][8 + 2 * r + 1]; }
            g[j] = (fminf(al, 0.f) - __logf(1.0f + __expf(-fabsf(al)))) * (1.0f / 16.0f); }
        kd[0] = __uint_as_float(R.kw << 16); kd[1] = __uint_as_float(R.kw & 0xffff0000u); }
    else {
#pragma unroll
        for (int j = 0; j < 2; ++j) { g[j] = j ? __uint_as_float(R.kw & 0xffff0000u) : __uint_as_float(R.kw << 16); kd[j] = 1.0f - __expf(g[j]); } }
}
template <int GRP> __device__ __forceinline__ unsigned sc_q_load(const ScanP& A, size_t row, int h, int k2) { return *(const unsigned*)(A.proj + row * NPS + (GRP ? C_HQ + h * 64 : C_GQ + h * 32) + k2); }
struct GateLite { unsigned gw, kw; };
__device__ __forceinline__ void sc_lite_load(const ScanP& A, size_t row, int h, int k2, int d, GateLite& R) { R.gw = *(const unsigned*)(A.AL + ((size_t)d * T + row) * 192 + h * 32 + k2); R.kw = *(const unsigned*)(A.proj + row * NPS + C_GK + h * 32 + k2); }
__device__ __forceinline__ void sc_lite(const GateLite& R, float (&g)[2], float (&kd)[2]) { g[0] = __uint_as_float(R.gw << 16); g[1] = __uint_as_float(R.gw & 0xffff0000u); kd[0] = __uint_as_float(R.kw << 16); kd[1] = __uint_as_float(R.kw & 0xffff0000u); }
template <int GRP> __device__ __forceinline__ void sc_q(unsigned w, float (&q)[2]) {
    if constexpr (GRP == 0) { q[0] = __uint_as_float(w << 16) * 0.17677669529663687f; q[1] = __uint_as_float(w & 0xffff0000u) * 0.17677669529663687f; }
    else { q[0] = __uint_as_float(w << 16); q[1] = __uint_as_float(w & 0xffff0000u); }
}
__device__ __forceinline__ void sc_vt_load(unsigned (&vw)[8], const pt* proj, size_t row0, int col0, int tid2) {
#pragma unroll
    for (int j = 0; j < 8; ++j) { const int idx = tid2 + 256 * j, vp = idx & 31, t = idx >> 5; vw[j] = *(const unsigned*)(proj + (row0 + t) * NPS + col0 + 2 * vp); }
}
__device__ __forceinline__ void sc_vt_store(LAS unsigned short* VT, const unsigned (&vw)[8], int tid2) {
#pragma unroll
    for (int j = 0; j < 8; ++j) { const int idx = tid2 + 256 * j, vp = idx & 31, t = idx >> 5; VT[(2 * vp) * 72 + t] = (unsigned short)(vw[j] & 0xffffu); VT[(2 * vp + 1) * 72 + t] = (unsigned short)(vw[j] >> 16); }
}
#define P1_CTX(d_) do { if constexpr (GRP == 0) { _Pragma("unroll") for (int r_ = 0; r_ < 16; ++r_) { const f32x2 w_ = *(const LAS f32x2*)(CW + ((d_) * 16 + r_) * 192 + ch * 32 + k2); cx.wa[0][r_] = w_[0]; cx.wa[1][r_] = w_[1]; } \
        const f32x2 b_ = *(const LAS f32x2*)(CW + 6144 + (d_) * 192 + ch * 32 + k2); cx.c0[0] = b_[0]; cx.c0[1] = b_[1]; } } while (0)
template <int GRP> __device__ __forceinline__ void scan_p1(LAS unsigned char* lds, const ScanP A, int wv_) {
    constexpr int K = GRP ? 64 : 32, KP = K / 2, NSEG = 256 / KP, SL = 64 / NSEG, CV = GRP ? C_HI : C_GV;
    const int tix = opaque_tid(), half = tix >> 8, tid2 = tix & 255, lane = tix & 63, w4 = __builtin_amdgcn_readfirstlane((tix >> 6) & 3), r = lane & 15, g4 = lane >> 4;
    LAS unsigned char* hl = lds + half * SC_HALF;
    LAS f32x2* TOT0 = (LAS f32x2*)hl; LAS f32x2* TOT1 = (LAS f32x2*)(hl + 4096);
    LAS unsigned short* VT = (LAS unsigned short*)(hl + 8192); LAS unsigned short* KT0 = (LAS unsigned short*)(hl + 17408); LAS unsigned short* KT1 = (LAS unsigned short*)(hl + 26624);
    const int kp = tid2 % KP, seg = tid2 / KP, k2 = 2 * kp;
    constexpr int NU = NB * 6 * SC_NCH;
    LAS unsigned short* S0 = (LAS unsigned short*)(hl + 35840); LAS unsigned short* S1 = S0 + 4608;
    LAS float* CW = (LAS float*)(lds + 2 * SC_HALF - 27648);
    if constexpr (GRP == 0) { for (int i = tix; i < 2 * 16 * 192 + 2 * 192; i += 512) CW[i] = i < 6144 ? A.wa2[i] : A.ba[i - 6144]; }
    const int tr = tid2 >> 3, o = tid2 & 7, t4 = tid2 >> 2, o4 = tid2 & 3;
    v4u ld0, ld1, ld2, ld3, ld4, ld5; int n, bh, h; size_t row0; bool active;
#define P1_UNIT(base_) do { const int unit_ = (base_) + 2 * (int)blockIdx.x + half; active = unit_ < NU; const int u_ = active ? NU - 1 - unit_ : 0;     n = u_ % SC_NCH; bh = u_ / SC_NCH; h = bh % 6; row0 = (size_t)(bh / 6) * SEQ_ + (size_t)n * 64; } while (0)
#define P1_LOAD() do { const pt* pr0 = A.proj + (row0 + tr) * NPS; const pt* pr1 = pr0 + (size_t)32 * NPS; ld0 = *(const v4u*)(pr0 + CV + h * 64 + 8 * o); ld1 = *(const v4u*)(pr1 + CV + h * 64 + 8 * o); \
        if constexpr (GRP == 1) { ld2 = *(const v4u*)(pr0 + C_HF + h * 64 + 8 * o); ld3 = *(const v4u*)(pr1 + C_HF + h * 64 + 8 * o); ld4 = *(const v4u*)(pr0 + C_HF + 384 + h * 64 + 8 * o); ld5 = *(const v4u*)(pr1 + C_HF + 384 + h * 64 + 8 * o); } \
        else { const pt* pq = A.proj + (row0 + t4) * NPS; ld2 = *(const v4u*)(pq + C_GK + h * 32 + 8 * o4); ld3 = *(const v4u*)(pq + C_GA + 8 * o4); } } while (0)
    P1_UNIT(0); P1_LOAD();
    LDS_BARRIER();
    for (int base = 0; base < NU; base += 2 * (int)gridDim.x) {
        const int cn = n, cbh = bh, ch = h; const size_t crow0 = row0; const bool cactive = active;
        GateRaw<GRP> rf[SL], rb[SL];
        { if constexpr (GRP == 1) { *(LAS v4u*)(S0 + tr * 72 + 8 * o) = ld2; *(LAS v4u*)(S0 + (tr + 32) * 72 + 8 * o) = ld3; *(LAS v4u*)(S1 + tr * 72 + 8 * o) = ld4; *(LAS v4u*)(S1 + (tr + 32) * 72 + 8 * o) = ld5; }
          else { *(LAS v4u*)(S0 + t4 * 40 + 8 * o4) = ld2; *(LAS v4u*)(S1 + t4 * 40 + 8 * o4) = ld3; }
          const v4u vv0 = ld0, vv1 = ld1;
#pragma unroll
          for (int i = 0; i < 4; ++i) { VT[(8 * o + 2 * i) * 72 + tr] = (unsigned short)(vv0[i] & 0xffffu); VT[(8 * o + 2 * i + 1) * 72 + tr] = (unsigned short)(vv0[i] >> 16);
              VT[(8 * o + 2 * i) * 72 + tr + 32] = (unsigned short)(vv1[i] & 0xffffu); VT[(8 * o + 2 * i + 1) * 72 + tr + 32] = (unsigned short)(vv1[i] >> 16); }
          LDS_BARRIER();
#pragma unroll
          for (int m = 0; m < SL; ++m) { const int t = seg * SL + m;
              if constexpr (GRP == 1) { rf[m].kw = *(const LAS unsigned*)(S0 + t * 72 + k2); rb[m].kw = *(const LAS unsigned*)(S1 + t * 72 + k2); }
              else { rf[m].kw = *(const LAS unsigned*)(S0 + t * 40 + k2); rb[m].kw = rf[m].kw; rf[m].a0 = *(const LAS v4u*)(S1 + t * 40); rf[m].a1 = *(const LAS v4u*)(S1 + t * 40 + 8); rb[m].a0 = *(const LAS v4u*)(S1 + t * 40 + 16); rb[m].a1 = *(const LAS v4u*)(S1 + t * 40 + 24); } }
        }
        float kf[SL][2], kbk[SL][2], gf[SL][2], gb[SL][2];
        { GateCtx cx; P1_CTX(0);
#pragma unroll
          for (int m = 0; m < SL; ++m) sc_gate<GRP>(cx, rf[m], gf[m], kf[m]);
          P1_CTX(1);
#pragma unroll
          for (int m = 0; m < SL; ++m) sc_gate<GRP>(cx, rb[m], gb[m], kbk[m]); }
        if constexpr (GRP == 0) { if (cactive) {
#pragma unroll
            for (int m = 0; m < SL; ++m) { const size_t row = crow0 + seg * SL + m; *(unsigned*)(A.AL + row * 192 + ch * 32 + k2) = cvtpk(gf[m][0], gf[m][1]); *(unsigned*)(A.AL + ((size_t)T + row) * 192 + ch * 32 + k2) = cvtpk(gb[m][0], gb[m][1]); } } }
        float ef[SL][2], eb[SL][2], tf[2] = {0.f, 0.f}, tb[2] = {0.f, 0.f};
#pragma unroll
        for (int m = SL - 1; m >= 0; --m) { ef[m][0] = tf[0]; ef[m][1] = tf[1]; tf[0] += gf[m][0]; tf[1] += gf[m][1]; }
#pragma unroll
        for (int m = 0; m < SL; ++m) { eb[m][0] = tb[0]; eb[m][1] = tb[1]; tb[0] += gb[m][0]; tb[1] += gb[m][1]; }
        TOT0[seg * KP + kp] = (f32x2){tf[0], tf[1]}; TOT1[seg * KP + kp] = (f32x2){tb[0], tb[1]};
        LDS_BARRIER();
        float af[2] = {0.f, 0.f}, ab[2] = {0.f, 0.f}, allf[2] = {0.f, 0.f}, allb[2] = {0.f, 0.f};
#pragma unroll
        for (int s2 = 0; s2 < NSEG; ++s2) { const f32x2 a = TOT0[s2 * KP + kp], c = TOT1[s2 * KP + kp]; allf[0] += a[0]; allf[1] += a[1]; allb[0] += c[0]; allb[1] += c[1];
            if (s2 > seg) { af[0] += a[0]; af[1] += a[1]; } if (s2 < seg) { ab[0] += c[0]; ab[1] += c[1]; } }
#pragma unroll
        for (int j = 0; j < 2; ++j)
#pragma unroll
            for (int m = 0; m < SL; m += 2) { const int t = seg * SL + m;
                *(LAS unsigned*)(KT0 + (k2 + j) * 72 + t) = cvtpk(kf[m][j] * __expf(af[j] + ef[m][j]), kf[m + 1][j] * __expf(af[j] + ef[m + 1][j]));
                *(LAS unsigned*)(KT1 + (k2 + j) * 72 + t) = cvtpk(kbk[m][j] * __expf(ab[j] + eb[m][j]), kbk[m + 1][j] * __expf(ab[j] + eb[m + 1][j])); }
        if (seg == 0 && cactive) { const size_t sd = (size_t)cbh * 2; *(f32x2*)(A.DD + ((sd + 0) * SC_NCH + cn) * K + k2) = (f32x2){__expf(allf[0]), __expf(allf[1])}; *(f32x2*)(A.DD + ((sd + 1) * SC_NCH + cn) * K + k2) = (f32x2){__expf(allb[0]), __expf(allb[1])}; }
        LDS_BARRIER();
        if (base + 2 * (int)gridDim.x < NU) { P1_UNIT(base + 2 * (int)gridDim.x); P1_LOAD(); }
        __builtin_amdgcn_sched_barrier(0);
#pragma unroll
        for (int d = 0; d < 2; ++d) { const LAS unsigned short* KTd = d ? KT1 : KT0; pt* dsu = A.DS + (((size_t)cbh * 2 + d) * SC_NCH + cn) * (size_t)(64 * K);
#pragma unroll
            for (int kb = 0; kb < K / 16; ++kb) { f32x4 acc = {0.f, 0.f, 0.f, 0.f};
#pragma unroll
                for (int kk = 0; kk < 2; ++kk) { const sbf16x8 af8 = *(const LAS sbf16x8*)(KTd + (16 * kb + r) * 72 + 32 * kk + 8 * g4), bfr = *(const LAS sbf16x8*)(VT + (16 * w4 + r) * 72 + 32 * kk + 8 * g4);
                    acc = __builtin_amdgcn_mfma_f32_16x16x32_bf16(af8, bfr, acc, 0, 0, 0); }
                if (cactive) { v2u o; o.x = cvtpk(acc[0], acc[1]); o.y = cvtpk(acc[2], acc[3]); *(v2u*)(dsu + (size_t)(16 * w4 + r) * K + 16 * kb + 4 * g4) = o; } } }
        LDS_BARRIER();
    }
}
#undef P1_UNIT
#undef P1_LOAD
#undef P1_CTX

__device__ __forceinline__ void scan_p2(pt* DS_gla, float* DD_gla, pt* DS_hg, float* DD_hg, size_t id) {
    const bool hg = id < (size_t)NB * 6 * 2 * 1024; const int K = hg ? 64 : 32; const size_t i2 = hg ? id : id - (size_t)NB * 6 * 2 * 1024;
    const int per = 64 * K / 4; const int sd = (int)(i2 / per), rem = (int)(i2 % per), v = rem / (K / 4), kq = rem % (K / 4), d = sd & 1;
    pt* ds = (hg ? DS_hg : DS_gla) + (size_t)sd * SC_NCH * 64 * K + (size_t)v * K + 4 * kq; const float* dd = (hg ? DD_hg : DD_gla) + (size_t)sd * SC_NCH * K + 4 * kq;
    float S0 = 0.f, S1 = 0.f, S2 = 0.f, S3 = 0.f;
    for (int nb = 0; nb < SC_NCH; nb += 8) {
        v2u dv[8]; f32x4 de[8];
#pragma unroll
        for (int j = 0; j < 8; ++j) { const int nn = nb + j, n = d ? SC_NCH - 1 - nn : nn; dv[j] = *(const v2u*)(ds + (size_t)n * 64 * K); de[j] = *(const f32x4*)(dd + (size_t)n * K); }
#pragma unroll
        for (int j = 0; j < 8; ++j) { const int nn = nb + j, n = d ? SC_NCH - 1 - nn : nn;
            v2u o; o.x = cvtpk(S0, S1); o.y = cvtpk(S2, S3); *(v2u*)(ds + (size_t)n * 64 * K) = o;
            S0 = de[j][0] * S0 + __uint_as_float(dv[j].x << 16); S1 = de[j][1] * S1 + __uint_as_float(dv[j].x & 0xffff0000u); S2 = de[j][2] * S2 + __uint_as_float(dv[j].y << 16); S3 = de[j][3] * S3 + __uint_as_float(dv[j].y & 0xffff0000u); }
    }
}
template <int GRP> __device__ __forceinline__ void scan_p3(LAS unsigned char* lds, const ScanP A, int wv_) {
    constexpr int K = GRP ? 64 : 32, KS = K + 8, KP = K / 2, NSEG = 256 / KP, SL = 64 / NSEG, SPB = NSEG / 4, CV = GRP ? C_HI : C_GV, CGATE = GRP ? C_HGT : C_GG, COUT = GRP ? 384 : 0;
    const int tix = opaque_tid(), half = tix >> 8, tid2 = tix & 255, lane = tix & 63, w4 = __builtin_amdgcn_readfirstlane((tix >> 6) & 3), r = lane & 15, g4 = lane >> 4;
    LAS unsigned char* hl = lds + half * SC_HALF;
    LAS f32x2* TOT = (LAS f32x2*)hl;
    LAS unsigned short* AM = (LAS unsigned short*)(hl + 4096);
    LAS unsigned short* KH = AM + 4 * 4608; LAS unsigned short* KT = AM + 5 * 4608; LAS unsigned short* VT = AM + 6 * 4608;
    LAS unsigned short* PS = AM; LAS unsigned short* YS = AM + 4608;
    const int kp = tid2 % KP, seg = tid2 / KP, k2 = 2 * kp, I = seg / SPB;
    constexpr int NU = NB * 6 * SC_NCH;
    unsigned qw[SL], vw[8]; typedef typename std::conditional<GRP == 0, GateLite, GateRaw<1>>::type GR; GR rg[SL]; sbf16x8 sf[K / 32][4]; v4u gv[2];
    int n, bh, h; size_t row0; bool active;
    LAS float* GN = (LAS float*)(hl + 2048);
    for (int i = tid2; i < 384; i += 256) GN[i] = A.gain[i];
#define SC_UNIT(base_) do { const int unit_ = (base_) + 2 * (int)blockIdx.x + half; active = unit_ < NU; const int u_ = active ? unit_ : 0; n = u_ % SC_NCH; bh = u_ / SC_NCH; h = bh % 6; row0 = (size_t)(bh / 6) * SEQ_ + (size_t)n * 64; } while (0)
#define SC_LOAD_SF(d_) do { const pt* st_ = A.DS + (((size_t)bh * 2 + (d_)) * SC_NCH + n) * (size_t)(64 * K); _Pragma("unroll") for (int kk = 0; kk < K / 32; ++kk) _Pragma("unroll") for (int vb = 0; vb < 4; ++vb) \
            sf[kk][vb] = *(const sbf16x8*)(st_ + (size_t)(16 * vb + r) * K + 32 * kk + 8 * g4); } while (0)
#define SC_LOAD_TOP() do { _Pragma("unroll") for (int m = 0; m < SL; ++m) { qw[m] = sc_q_load<GRP>(A, row0 + seg * SL + m, h, k2); if constexpr (GRP == 0) sc_lite_load(A, row0 + seg * SL + m, h, k2, 0, (GateLite&)rg[m]); else sc_gate_load<1>(A, row0 + seg * SL + m, h, k2, 0, (GateRaw<1>&)rg[m]); } \
            sc_vt_load(vw, A.proj, row0, CV + h * 64, tid2); } while (0)
    SC_UNIT(0); SC_LOAD_TOP(); __builtin_amdgcn_sched_barrier(0);
    for (int base = 0; base < NU; base += 2 * (int)gridDim.x) {
        const size_t crow0 = row0; const int ch = h; const bool cactive = active;
        SC_LOAD_SF(0);
        __builtin_amdgcn_sched_barrier(0);
        unsigned qp[SL];
#pragma unroll
        for (int m = 0; m < SL; ++m) { float qf[2]; sc_q<GRP>(qw[m], qf); qp[m] = cvtpk(qf[0], qf[1]); }
        sc_vt_store(VT, vw, tid2);
        f32x4 P[4], O[4];
#pragma unroll
        for (int j = 0; j < 4; ++j) { P[j] = (f32x4){0.f, 0.f, 0.f, 0.f}; O[j] = (f32x4){0.f, 0.f, 0.f, 0.f}; }
#pragma unroll
        for (int d = 0; d < 2; ++d) {
            unsigned krp[SL]; float c[SL][2], tot[2] = {0.f, 0.f};
            { GateCtx cx; if constexpr (GRP == 1) sc_ctx<1>(A, h, k2, d, cx);
#pragma unroll
              for (int m = 0; m < SL; ++m) { float kf_[2]; if constexpr (GRP == 0) sc_lite((const GateLite&)rg[m], c[m], kf_); else sc_gate<1>(cx, (const GateRaw<1>&)rg[m], c[m], kf_); krp[m] = cvtpk(kf_[0], kf_[1]); } }
            if (d == 0) {
#pragma unroll
                for (int m = 0; m < SL; ++m) { if constexpr (GRP == 0) sc_lite_load(A, row0 + seg * SL + m, h, k2, 1, (GateLite&)rg[m]); else sc_gate_load<1>(A, row0 + seg * SL + m, h, k2, 1, (GateRaw<1>&)rg[m]); } }
            if (d == 0) {
#pragma unroll
                for (int m = 0; m < SL; ++m) { tot[0] += c[m][0]; tot[1] += c[m][1]; c[m][0] = tot[0]; c[m][1] = tot[1]; } }
            else {
#pragma unroll
                for (int m = SL - 1; m >= 0; --m) { tot[0] += c[m][0]; tot[1] += c[m][1]; c[m][0] = tot[0]; c[m][1] = tot[1]; } }
            TOT[seg * KP + kp] = (f32x2){tot[0], tot[1]};
            LDS_BARRIER();
            float Pr[5][2], bs[2] = {0.f, 0.f};
            { float run[2] = {0.f, 0.f}; Pr[0][0] = 0.f; Pr[0][1] = 0.f;
#pragma unroll
              for (int s3 = 0; s3 < NSEG; ++s3) { const int s2 = d == 0 ? s3 : NSEG - 1 - s3; const f32x2 a = TOT[s2 * KP + kp];
                  if (s2 == seg) { bs[0] = run[0]; bs[1] = run[1]; }
                  run[0] += a[0]; run[1] += a[1];
                  if ((s3 % SPB) == SPB - 1) { Pr[s3 / SPB + 1][0] = run[0]; Pr[s3 / SPB + 1][1] = run[1]; } } }
            const int Iv = d == 0 ? I : 3 - I;
            float rp[2], ro[2], M1[2], M2[2], M3[2], FH[2];
#pragma unroll
            for (int j = 0; j < 2; ++j) { float rb1 = 0.f, rb2 = 0.f, rb3 = 0.f; rp[j] = 0.f; ro[j] = 0.f;
#pragma unroll
                for (int x = 0; x < 4; ++x) { if (Iv == x) { rp[j] = Pr[x][j]; ro[j] = Pr[x + 1][j]; rb1 = Pr[x > 0 ? x - 1 : 0][j]; rb2 = Pr[x > 1 ? x - 2 : 0][j]; rb3 = Pr[x > 2 ? x - 3 : 0][j]; } }
                M1[j] = __expf(rp[j] - rb1); M2[j] = __expf(rp[j] - rb2); M3[j] = __expf(rp[j] - rb3); FH[j] = __expf(fminf(rp[j] - ro[j], 80.f)); }
#pragma unroll
            for (int m = 0; m < SL; ++m) { const int t = seg * SL + m; float a0[2], kt[2];
#pragma unroll
                for (int j = 0; j < 2; ++j) { const float Gt = bs[j] + c[m][j]; a0[j] = (j ? __uint_as_float(qp[m] & 0xffff0000u) : __uint_as_float(qp[m] << 16)) * __expf(Gt - rp[j]); kt[j] = (j ? __uint_as_float(krp[m] & 0xffff0000u) : __uint_as_float(krp[m] << 16)) * __expf(ro[j] - Gt); }
                LAS unsigned short* ap = AM + t * KS + k2;
                *(LAS unsigned*)(ap) = cvtpk(a0[0], a0[1]); *(LAS unsigned*)(ap + 4608) = cvtpk(a0[0] * M1[0], a0[1] * M1[1]);
                *(LAS unsigned*)(ap + 2 * 4608) = cvtpk(a0[0] * M2[0], a0[1] * M2[1]); *(LAS unsigned*)(ap + 3 * 4608) = cvtpk(a0[0] * M3[0], a0[1] * M3[1]);
                *(LAS unsigned*)(KT + t * KS + k2) = cvtpk(kt[0], kt[1]); *(LAS unsigned*)(KH + t * KS + k2) = cvtpk(kt[0] * FH[0], kt[1] * FH[1]); }
            LDS_BARRIER();
            { const int Iw = w4; const int lvi = d == 0 ? Iw : 3 - Iw;
              const LAS unsigned short* ai = AM + lvi * 4608 + (16 * Iw + r) * KS + 8 * g4;
#pragma unroll
              for (int kk = 0; kk < K / 32; ++kk) { const sbf16x8 af = *(const LAS sbf16x8*)(ai + 32 * kk);
#pragma unroll
                  for (int vb = 0; vb < 4; ++vb) O[vb] = __builtin_amdgcn_mfma_f32_16x16x32_bf16(af, sf[kk][vb], O[vb], 0, 0, 0); }
#pragma unroll
              for (int J = 0; J < 4; ++J) {
                  if (J == Iw) { f32x4 tm = {0.f, 0.f, 0.f, 0.f};
#pragma unroll
                      for (int kk = 0; kk < K / 32; ++kk) { const sbf16x8 af = *(const LAS sbf16x8*)(AM + (16 * Iw + r) * KS + 32 * kk + 8 * g4), bfr = *(const LAS sbf16x8*)(KH + (16 * J + r) * KS + 32 * kk + 8 * g4);
                          tm = __builtin_amdgcn_mfma_f32_16x16x32_bf16(af, bfr, tm, 0, 0, 0); }
#pragma unroll
                      for (int e = 0; e < 4; ++e) { const int tl = 4 * g4 + e; const bool keep = d == 0 ? (r <= tl) : (r >= tl); P[J][e] += keep ? tm[e] : 0.f; } }
                  else if ((d == 0 && J < Iw) || (d == 1 && J > Iw)) { const int lv = (d == 0 ? Iw - J : J - Iw) - 1;
#pragma unroll
                      for (int kk = 0; kk < K / 32; ++kk) { const sbf16x8 af = *(const LAS sbf16x8*)(AM + lv * 4608 + (16 * Iw + r) * KS + 32 * kk + 8 * g4), bfr = *(const LAS sbf16x8*)(KT + (16 * J + r) * KS + 32 * kk + 8 * g4);
                          P[J] = __builtin_amdgcn_mfma_f32_16x16x32_bf16(af, bfr, P[J], 0, 0, 0); } }
              } }
            if (d == 0) { SC_LOAD_SF(1); __builtin_amdgcn_sched_barrier(0); }
            else {
#pragma unroll
                for (int j = 0; j < 2; ++j) { const int it = tid2 + 256 * j, t = it >> 3, v8 = (it & 7) * 8; gv[j] = *(const v4u*)(A.proj + (row0 + t) * NPS + CGATE + h * 64 + v8); }
                if (base + 2 * (int)gridDim.x < NU) { SC_UNIT(base + 2 * (int)gridDim.x); SC_LOAD_TOP(); }
                __builtin_amdgcn_sched_barrier(0); }
            LDS_BARRIER();
        }
#pragma unroll
        for (int J = 0; J < 4; ++J)
#pragma unroll
            for (int e = 0; e < 4; ++e) PS[(16 * w4 + 4 * g4 + e) * 72 + 16 * J + r] = (unsigned short)(cvtpk(P[J][e], P[J][e]) & 0xffffu);
        LDS_BARRIER();
#pragma unroll
        for (int kk = 0; kk < 2; ++kk) { const sbf16x8 af = *(const LAS sbf16x8*)(PS + (16 * w4 + r) * 72 + 32 * kk + 8 * g4);
#pragma unroll
            for (int vb = 0; vb < 4; ++vb) { const sbf16x8 bfr = *(const LAS sbf16x8*)(VT + (16 * vb + r) * 72 + 32 * kk + 8 * g4); O[vb] = __builtin_amdgcn_mfma_f32_16x16x32_bf16(af, bfr, O[vb], 0, 0, 0); } }
        float rs[4];
#pragma unroll
        for (int e = 0; e < 4; ++e) { float ss = O[0][e] * O[0][e] + O[1][e] * O[1][e] + O[2][e] * O[2][e] + O[3][e] * O[3][e];
            ss = rowsum16(ss); rs[e] = rsqrtf(ss * (1.0f / 64.0f) + RMS_EPS); }
#pragma unroll
        for (int vb = 0; vb < 4; ++vb)
#pragma unroll
            for (int e = 0; e < 4; ++e) YS[(16 * w4 + 4 * g4 + e) * 72 + 16 * vb + r] = (unsigned short)(cvtpk(O[vb][e] * rs[e], 0.f) & 0xffffu);
        LDS_BARRIER();
#pragma unroll
        for (int j = 0; j < 2; ++j) { const int it = tid2 + 256 * j, t = it >> 3, v8 = (it & 7) * 8;
            const v4u yv = *(const LAS v4u*)(YS + t * 72 + v8); const f32x4 gn0 = *(const LAS f32x4*)(GN + ch * 64 + v8), gn1 = *(const LAS f32x4*)(GN + ch * 64 + v8 + 4);
            float o[8];
#pragma unroll
            for (int e = 0; e < 8; ++e) { const unsigned yw = yv[e >> 1], gw = gv[j][e >> 1]; const float yf = __uint_as_float((e & 1) ? (yw & 0xffff0000u) : (yw << 16)), gf = __uint_as_float((e & 1) ? (gw & 0xffff0000u) : (gw << 16));
                o[e] = yf * (e < 4 ? gn0[e] : gn1[e - 4]) * gf; }
            if (cactive) { v4u ov; ov.x = cvtpk(o[0], o[1]); ov.y = cvtpk(o[2], o[3]); ov.z = cvtpk(o[4], o[5]); ov.w = cvtpk(o[6], o[7]);
                *(v4u*)(A.mixin + (crow0 + t) * (size_t)A.ms + COUT + ch * 64 + v8) = ov; } }
        LDS_BARRIER();
    }
}
#undef SC_UNIT
#undef SC_LOAD_SF
#undef SC_LOAD_TOP

__device__ __forceinline__ float wsum(float v) { v = rowsum16(v); return (rdlane(v, 0) + rdlane(v, 16)) + (rdlane(v, 32) + rdlane(v, 48)); }
__device__ __forceinline__ float bfl(unsigned w) { return __uint_as_float(w << 16); }
__device__ __forceinline__ float bfh(unsigned w) { return __uint_as_float(w & 0xffff0000u); }
struct LnGB { f32x4 g[4], b[4]; };
__device__ __forceinline__ LnGB ln_gb(const float* g, const float* be, int lane) { LnGB r;
#pragma unroll
    for (int j = 0; j < 4; ++j) { r.g[j] = *(const f32x4*)(g + 256 * j + 4 * lane); r.b[j] = *(const f32x4*)(be + 256 * j + 4 * lane); }
    return r; }
__device__ __forceinline__ void ln_finish(f32x4 (&v)[4], const LnGB& gb, float* hrow, pt* xrow, int lane) {
    float s = 0.f;
#pragma unroll
    for (int j = 0; j < 4; ++j) s += (v[j][0] + v[j][1]) + (v[j][2] + v[j][3]);
    const float mean = wsum(s) * (1.0f / DM); float q = 0.f;
#pragma unroll
    for (int j = 0; j < 4; ++j) { v[j] = v[j] - mean; q += (v[j][0] * v[j][0] + v[j][1] * v[j][1]) + (v[j][2] * v[j][2] + v[j][3] * v[j][3]); }
    const float rstd = 1.0f / sqrtf(wsum(q) * (1.0f / DM) + LN_EPS);
#pragma unroll
    for (int j = 0; j < 4; ++j) {
        v[j] = v[j] * rstd * gb.g[j] + gb.b[j]; if (hrow) *(f32x4*)(hrow + 256 * j + 4 * lane) = v[j];
        if (xrow) { v2u o; o.x = cvtpk(v[j][0], v[j][1]); o.y = cvtpk(v[j][2], v[j][3]); *(v2u*)(xrow + 256 * j + 4 * lane) = o; } }
}
__device__ __forceinline__ void ln_finish_l(f32x4 (&v)[4], const LAS float* gl, float* hrow, pt* xrow, int lane) {
    float s = 0.f;
#pragma unroll
    for (int j = 0; j < 4; ++j) s += (v[j][0] + v[j][1]) + (v[j][2] + v[j][3]);
    const float mean = wsum(s) * (1.0f / DM); float q = 0.f;
#pragma unroll
    for (int j = 0; j < 4; ++j) { v[j] = v[j] - mean; q += (v[j][0] * v[j][0] + v[j][1] * v[j][1]) + (v[j][2] * v[j][2] + v[j][3] * v[j][3]); }
    const float rstd = 1.0f / sqrtf(wsum(q) * (1.0f / DM) + LN_EPS);
#pragma unroll
    for (int j = 0; j < 4; ++j) {
        v[j] = v[j] * rstd * *(const LAS f32x4*)(gl + 256 * j + 4 * lane) + *(const LAS f32x4*)(gl + 1024 + 256 * j + 4 * lane); if (hrow) *(f32x4*)(hrow + 256 * j + 4 * lane) = v[j];
        if (xrow) { v2u o; o.x = cvtpk(v[j][0], v[j][1]); o.y = cvtpk(v[j][2], v[j][3]); *(v2u*)(xrow + 256 * j + 4 * lane) = o; } }
}
template <int NW = 8, int U = 2> __device__ __forceinline__ void ew_ln_in(const float* x, const float* g, const float* be, float* H, pt* XB, int wv_) {
    const int tix = opaque_tid(), lane = tix & 63; const int gw = (tix >> 6) * gridDim.x + blockIdx.x, NGW = gridDim.x * NW;
    const LnGB gb = ln_gb(g, be, lane);
    f32x4 nx[U][4];
#pragma unroll
    for (int u = 0; u < U; ++u) if (gw + u * NGW < T) {
#pragma unroll
        for (int j = 0; j < 4; ++j) nx[u][j] = *(const f32x4*)(x + (size_t)(gw + u * NGW) * DM + 256 * j + 4 * lane); }
    for (int row0 = gw; row0 < T; row0 += U * NGW) {
#pragma unroll
        for (int u = 0; u < U; ++u) { const int row = row0 + u * NGW; if (row < T) { f32x4 v[4];
#pragma unroll
            for (int j = 0; j < 4; ++j) v[j] = nx[u][j];
            if (row + U * NGW < T) {
#pragma unroll
                for (int j = 0; j < 4; ++j) nx[u][j] = *(const f32x4*)(x + (size_t)(row + U * NGW) * DM + 256 * j + 4 * lane); }
            ln_finish(v, gb, H ? H + (size_t)row * DM : nullptr, XB + (size_t)row * DM, lane); } } }
}
template <bool MIXBF, bool RESBF = false, int U = 2> __device__ __forceinline__ void ew_ln1_route(LAS unsigned char* lds, const void* Hres, float* H, const void* MIXv, const float* g, const float* be, pt* XB,
        const float* wrg, const float* brg, const float* wre, const float* bre, int* RE, float* RW, int* CNT, int wv_) {
    const int tix = opaque_tid(), lane = tix & 63, wave = tix >> 6; const int gw = wave * gridDim.x + blockIdx.x, NGW = gridDim.x * 8;
    LAS f32x4* TG = (LAS f32x4*)lds;
    LAS f32x4* TE = (LAS f32x4*)(lds + 16384);
    LAS int* LC = (LAS int*)(lds + 16384 + 65536);
    for (int i = tix; i < 1024; i += 512) { const int c = i; const int j = c >> 8, ln = (c & 255) >> 2, e = c & 3, slot = (j * 4 + e) * 64 + ln;
        TG[slot] = *(const f32x4*)(wrg + (size_t)c * 4);
#pragma unroll
        for (int gi = 0; gi < 4; ++gi) TE[gi * 1024 + slot] = *(const f32x4*)(wre + (size_t)c * 16 + gi * 4); }
    LAS float* TB = (LAS float*)(lds + 16384 + 65536 + 64);
    if (tix < 16) { LC[tix] = 0; TB[tix] = bre[tix]; }
    __syncthreads();
    const f32x4 bg = *(const f32x4*)brg; const LnGB gb = ln_gb(g, be, lane);
    f32x4 nh[U][4]; v2u nhb[U][4]; v2u nm[U][4]; f32x4 nmf[U][4];
#define LN1_LOAD(u_, r_) do { _Pragma("unroll") for (int j = 0; j < 4; ++j) { if constexpr (RESBF) nhb[u_][j] = *(const v2u*)((const pt*)Hres + (size_t)(r_) * DM + 256 * j + 4 * lane); else nh[u_][j] = *(const f32x4*)((const float*)Hres + (size_t)(r_) * DM + 256 * j + 4 * lane); \
        if constexpr (MIXBF) nm[u_][j] = *(const v2u*)((const pt*)MIXv + (size_t)(r_) * DM + 256 * j + 4 * lane); else nmf[u_][j] = *(const f32x4*)((const float*)MIXv + (size_t)(r_) * DM + 256 * j + 4 * lane); } } while (0)
#pragma unroll
    for (int u = 0; u < U; ++u) if (gw + u * NGW < T) LN1_LOAD(u, gw + u * NGW);
    for (int row0 = gw; row0 < T; row0 += U * NGW)
#pragma unroll
    for (int u = 0; u < U; ++u) { const int row = row0 + u * NGW; if (row >= T) break; f32x4 v[4];
#pragma unroll
        for (int j = 0; j < 4; ++j) { f32x4 mx;
            if constexpr (MIXBF) mx = (f32x4){bfl(nm[u][j].x), bfh(nm[u][j].x), bfl(nm[u][j].y), bfh(nm[u][j].y)}; else mx = nmf[u][j];
            f32x4 hr; if constexpr (RESBF) hr = (f32x4){bfl(nhb[u][j].x), bfh(nhb[u][j].x), bfl(nhb[u][j].y), bfh(nhb[u][j].y)}; else hr = nh[u][j];
            v[j] = hr * ALPHA + mx; }
        if (row + U * NGW < T) LN1_LOAD(u, row + U * NGW);
        ln_finish(v, gb, H ? H + (size_t)row * DM : nullptr, XB + (size_t)row * DM, lane);
        f32x4 lg = {0.f, 0.f, 0.f, 0.f};
#pragma unroll
        for (int j = 0; j < 4; ++j)
#pragma unroll
            for (int e = 0; e < 4; ++e) lg += TG[(j * 4 + e) * 64 + lane] * v[j][e];
        lg[0] = wsum(lg[0]) + bg[0]; lg[1] = wsum(lg[1]) + bg[1]; lg[2] = wsum(lg[2]) + bg[2]; lg[3] = wsum(lg[3]) + bg[3];
        int gi = 0; float gm = lg[0];
        if (lg[1] > gm) { gm = lg[1]; gi = 1; } if (lg[2] > gm) { gm = lg[2]; gi = 2; } if (lg[3] > gm) { gm = lg[3]; gi = 3; }
        gi = __builtin_amdgcn_readfirstlane(gi);
        const float gval = __builtin_amdgcn_rcpf(__expf(lg[0] - gm) + __expf(lg[1] - gm) + __expf(lg[2] - gm) + __expf(lg[3] - gm));
        f32x4 le = {0.f, 0.f, 0.f, 0.f};
#pragma unroll
        for (int j = 0; j < 4; ++j)
#pragma unroll
            for (int e = 0; e < 4; ++e) le += TE[gi * 1024 + (j * 4 + e) * 64 + lane] * v[j][e];
        const f32x4 bev = *(const LAS f32x4*)(TB + gi * 4);
        le[0] = wsum(le[0]) + bev[0]; le[1] = wsum(le[1]) + bev[1]; le[2] = wsum(le[2]) + bev[2]; le[3] = wsum(le[3]) + bev[3];
        int e0 = 0; float v0 = le[0];
        if (le[1] > v0) { v0 = le[1]; e0 = 1; } if (le[2] > v0) { v0 = le[2]; e0 = 2; } if (le[3] > v0) { v0 = le[3]; e0 = 3; }
        int e1 = -1; float v1 = -3.0e38f;
        if (e0 != 0 && le[0] > v1) { v1 = le[0]; e1 = 0; } if (e0 != 1 && le[1] > v1) { v1 = le[1]; e1 = 1; }
        if (e0 != 2 && le[2] > v1) { v1 = le[2]; e1 = 2; } if (e0 != 3 && le[3] > v1) { v1 = le[3]; e1 = 3; }
        const float p1 = __expf(v1 - v0), w0 = __builtin_amdgcn_rcpf(1.0f + p1), w1 = p1 * w0;
        if (lane == 0) { RE[row * 2] = gi * 4 + e0; RE[row * 2 + 1] = gi * 4 + e1; RW[row * 2] = gval * w0; RW[row * 2 + 1] = gval * w1;
            __hip_atomic_fetch_add(LC + gi * 4 + e0, 1, __ATOMIC_RELAXED, __HIP_MEMORY_SCOPE_WORKGROUP); __hip_atomic_fetch_add(LC + gi * 4 + e1, 1, __ATOMIC_RELAXED, __HIP_MEMORY_SCOPE_WORKGROUP); }
    }
#undef LN1_LOAD
    __syncthreads();
    if (tix < 16) { const int c = LC[tix]; if (c) atomicAdd(CNT + tix, c); }
    __syncthreads();
}
__device__ __forceinline__ void ew_assign_gather(LAS unsigned char* lds, const int* RE, const int* CNT, int* CUR, int* SLOT, const pt* XB, pt* XS, int wv_, int* TOKR = nullptr) {
    const int tix = opaque_tid(), lane = tix & 63, wave = tix >> 6;
    LAS int* LC = (LAS int*)lds; LAS int* LB_ = LC + 16; LAS int* PS_ = LC + 32; LAS int* SL = LC + 64;
    for (int g0 = blockIdx.x; g0 < T / 128; g0 += gridDim.x) {
        if (tix < 16) { LC[tix] = 0; int acc = 0; for (int e = 0; e < 16; ++e) { if (e == tix) PS_[tix] = acc; acc += (CNT[e] + 255) / 256 * 256; } }
        __syncthreads();
        int e = 0, rank = 0;
        if (tix < 256) { e = RE[g0 * 256 + tix]; rank = __hip_atomic_fetch_add(LC + e, 1, __ATOMIC_RELAXED, __HIP_MEMORY_SCOPE_WORKGROUP); }
        __syncthreads();
        if (tix < 16) LB_[tix] = LC[tix] ? atomicAdd(CUR + tix, LC[tix]) : 0;
        __syncthreads();
        if (tix < 256) { const int s = PS_[e] + LB_[e] + rank; SLOT[g0 * 256 + tix] = s; SL[tix] = s; if (TOKR) TOKR[s] = g0 * 128 + (tix >> 1); }
        __syncthreads();
        if (TOKR) continue;
        for (int a = wave; a < 256; a += 32) {
            v4u r0[4], r1[4];
#pragma unroll
            for (int q = 0; q < 4; ++q) { const int t = g0 * 128 + ((a + 8 * q) >> 1); const v4u* src = (const v4u*)(XB + (size_t)t * DM); r0[q] = src[lane]; r1[q] = src[lane + 64]; }
#pragma unroll
            for (int q = 0; q < 4; ++q) { const int s = SL[a + 8 * q]; v4u* dst = (v4u*)(XS + (size_t)s * DM); dst[lane] = r0[q]; dst[lane + 64] = r1[q]; } }
        __syncthreads();
    }
}
template <bool RESBF = false, int U = 2> __device__ __forceinline__ void ew_ln2(const void* Hres, float* H, const pt* Y, const int* SLOT, const float* RW, const float* g, const float* be, pt* XB, int wv_) {
    const int tix = opaque_tid(), lane = tix & 63; const int gw = (tix >> 6) * gridDim.x + blockIdx.x, NGW = gridDim.x * 8;
    const LnGB gb = ln_gb(g, be, lane);
    f32x4 nh[U][4]; v2u nhb[U][4]; v2u na[U][4], nb[U][4]; float nw0[U], nw1[U];
    int ps0[U], ps1[U]; float pw0[U], pw1[U];
#define LN2_IDX(u_, r_) do { ps0[u_] = SLOT[2 * (r_)]; ps1[u_] = SLOT[2 * (r_) + 1]; pw0[u_] = RW[2 * (r_)]; pw1[u_] = RW[2 * (r_) + 1]; } while (0)
#define LN2_LOAD(u_, r_) do { const int s0_ = ps0[u_], s1_ = ps1[u_]; nw0[u_] = pw0[u_]; nw1[u_] = pw1[u_]; _Pragma("unroll") for (int j = 0; j < 4; ++j) { \
        if constexpr (RESBF) nhb[u_][j] = *(const v2u*)((const pt*)Hres + (size_t)(r_) * DM + 256 * j + 4 * lane); else nh[u_][j] = *(const f32x4*)((const float*)Hres + (size_t)(r_) * DM + 256 * j + 4 * lane); na[u_][j] = *(const v2u*)(Y + (size_t)s0_ * DM + 256 * j + 4 * lane); nb[u_][j] = *(const v2u*)(Y + (size_t)s1_ * DM + 256 * j + 4 * lane); } } while (0)
#pragma unroll
    for (int u = 0; u < U; ++u) { nw0[u] = 0.f; nw1[u] = 0.f; ps0[u] = ps1[u] = 0; pw0[u] = pw1[u] = 0.f; if (gw + u * NGW < T) LN2_IDX(u, gw + u * NGW); }
#pragma unroll
    for (int u = 0; u < U; ++u) { if (gw + u * NGW < T) LN2_LOAD(u, gw + u * NGW); if (gw + (U + u) * NGW < T) LN2_IDX(u, gw + (U + u) * NGW); }
    for (int row0 = gw; row0 < T; row0 += U * NGW)
#pragma unroll
    for (int u = 0; u < U; ++u) { const int row = row0 + u * NGW; if (row >= T) break; f32x4 v[4]; const float w0 = nw0[u], w1 = nw1[u];
#pragma unroll
        for (int j = 0; j < 4; ++j) { const f32x4 ya = {bfl(na[u][j].x), bfh(na[u][j].x), bfl(na[u][j].y), bfh(na[u][j].y)}, yb = {bfl(nb[u][j].x), bfh(nb[u][j].x), bfl(nb[u][j].y), bfh(nb[u][j].y)};
            f32x4 hr; if constexpr (RESBF) hr = (f32x4){bfl(nhb[u][j].x), bfh(nhb[u][j].x), bfl(nhb[u][j].y), bfh(nhb[u][j].y)}; else hr = nh[u][j];
            v[j] = hr * ALPHA + (ya * w0 + yb * w1); }
        if (row + U * NGW < T) LN2_LOAD(u, row + U * NGW);
        if (row + 2 * U * NGW < T) LN2_IDX(u, row + 2 * U * NGW);
        ln_finish(v, gb, H ? H + (size_t)row * DM : nullptr, XB ? XB + (size_t)row * DM : nullptr, lane); }
#undef LN2_IDX
#undef LN2_LOAD
}
__device__ __forceinline__ void ew_hy_prep(LAS unsigned char* lds, const pt* proj, const float* cw, const float* cb, pt* u2t, int wv_) {
    const int tix = opaque_tid(); LAS unsigned short* TL = (LAS unsigned short*)lds;
    constexpr int NT = NB * (SEQ_ / 64) * 12;
    LAS float* CWL = (LAS float*)(lds + 16384);
    for (int i = tix; i < 4 * 768; i += 512) CWL[i] = i < 3 * 768 ? cw[i] : cb[i - 3 * 768];
    LDS_BARRIER();
    v4u pa = {0u, 0u, 0u, 0u}, pb = {0u, 0u, 0u, 0u};
#define PREP_LOAD(tile_) do { const int tr_ = NT - 1 - (tile_); const int c0_ = (tr_ % 12) * 64, t0_ = ((tr_ / 12) % (SEQ_ / 64)) * 64, b_ = tr_ / (12 * (SEQ_ / 64)); \
        { const int rr = tix >> 3, pc = tix & 7, t = t0_ - 1 + rr; pa = (v4u){0u, 0u, 0u, 0u}; if (t >= 0) pa = *(const v4u*)(proj + ((size_t)b_ * SEQ_ + t) * NPS + C_HY + c0_ + pc * 8); } \
        if (tix < 16) { const int rr = 64 + (tix >> 3), pc = tix & 7, t = t0_ - 1 + rr; pb = (v4u){0u, 0u, 0u, 0u}; if (t < SEQ_) pb = *(const v4u*)(proj + ((size_t)b_ * SEQ_ + t) * NPS + C_HY + c0_ + pc * 8); } } while (0)
    if ((int)blockIdx.x < NT) PREP_LOAD((int)blockIdx.x);
    for (int tile = blockIdx.x; tile < NT; tile += gridDim.x) {
        const int trv = NT - 1 - tile; const int c0 = (trv % 12) * 64, t0 = ((trv / 12) % (SEQ_ / 64)) * 64, b = trv / (12 * (SEQ_ / 64));
        *(LAS v4u*)(TL + (tix >> 3) * 72 + (tix & 7) * 8) = pa; if (tix < 16) *(LAS v4u*)(TL + (64 + (tix >> 3)) * 72 + (tix & 7) * 8) = pb;
        LDS_BARRIER();
        if (tile + (int)gridDim.x < NT) PREP_LOAD(tile + (int)gridDim.x);
        { const int cc = tix >> 3, t8 = tix & 7, c = c0 + cc; const float w0 = CWL[c], w1 = CWL[768 + c], w2 = CWL[1536 + c], bb = CWL[2304 + c];
          float x[10];
#pragma unroll
          for (int i = 0; i < 10; ++i) x[i] = __uint_as_float(((unsigned)TL[(8 * t8 + i) * 72 + cc]) << 16);
          unsigned o[4];
#pragma unroll
          for (int i = 0; i < 4; ++i) { const float a0 = bb + w0 * x[2 * i] + w1 * x[2 * i + 1] + w2 * x[2 * i + 2], a1 = bb + w0 * x[2 * i + 1] + w1 * x[2 * i + 2] + w2 * x[2 * i + 3]; o[i] = cvtpk(a0, a1); }
          *(v4u*)(u2t + ((size_t)b * 768 + c) * SEQ_ + t0 + 8 * t8) = (v4u){o[0], o[1], o[2], o[3]}; }
        LDS_BARRIER();
    }
#undef PREP_LOAD
}
__device__ __forceinline__ void ew_hy_tr(LAS unsigned char* lds, const pt* yt, pt* mixin, int ms, int wv_) {
    const int tix = opaque_tid(); LAS unsigned short* TL = (LAS unsigned short*)lds;
    constexpr int NT = NB * (SEQ_ / 64) * 4;
    v4u pa = {0u, 0u, 0u, 0u};
#define TR_LOAD(tile_) do { const int c0_ = ((tile_) % 4) * 64, t0_ = (((tile_) / 4) % (SEQ_ / 64)) * 64, b_ = (tile_) / (4 * (SEQ_ / 64)); pa = *(const v4u*)(yt + ((size_t)b_ * 256 + c0_ + (tix >> 3)) * SEQ_ + t0_ + 8 * (tix & 7)); } while (0)
    if ((int)blockIdx.x < NT) TR_LOAD((int)blockIdx.x);
    for (int tile = blockIdx.x; tile < NT; tile += gridDim.x) {
        const int c0 = (tile % 4) * 64, t0 = ((tile / 4) % (SEQ_ / 64)) * 64, b = tile / (4 * (SEQ_ / 64));
        *(LAS v4u*)(TL + (tix >> 3) * 72 + 8 * (tix & 7)) = pa;
        LDS_BARRIER();
        if (tile + (int)gridDim.x < NT) TR_LOAD(tile + (int)gridDim.x);
        { const int t = tix >> 3, j = tix & 7; unsigned short x[8];
#pragma unroll
          for (int i = 0; i < 8; ++i) x[i] = TL[(8 * j + i) * 72 + t];
          *(v4u*)(mixin + ((size_t)b * SEQ_ + t0 + t) * (size_t)ms + 768 + c0 + 8 * j) = (v4u){(unsigned)x[0] | ((unsigned)x[1] << 16), (unsigned)x[2] | ((unsigned)x[3] << 16), (unsigned)x[4] | ((unsigned)x[5] << 16), (unsigned)x[6] | ((unsigned)x[7] << 16)}; }
        LDS_BARRIER();
    }
#undef TR_LOAD
}
__device__ __forceinline__ void ew_hy_filter(LAS unsigned char* lds, const float* w1a, const float* b1a, const float* fqa, const float* w2a, const float* b2a, const float* w3a, pt* RF2, int wv_) {
    const int tix = opaque_tid(), lane = tix & 63, wave = tix >> 6; LAS unsigned short* TL = (LAS unsigned short*)lds;
    for (int i = blockIdx.x * 512 + tix; i < 1024 * 385; i += gridDim.x * 512) { const int rw = i / 385, j = i % 385; const int idx = j < 129 ? j : (2 * SEQ_ - 1) + j; RF2[(size_t)rw * RFL + idx] = 0; }
    for (int tile = blockIdx.x; tile < 2 * (SEQ_ / 64); tile += gridDim.x) {
        const int l = tile / (SEQ_ / 64), n0 = (tile % (SEQ_ / 64)) * 64;
        const float* w1 = w1a + l * 33 * 64; const float* b1 = b1a + l * 64; const float* fq = fqa + l * 64; const float* w2 = w2a + l * 2 * 4096; const float* b2 = b2a + l * 128; const float* w3 = w3a + (size_t)l * 64 * 1024;
        const float fr = fq[lane];
        float h3[8];
#pragma unroll
        for (int i = 0; i < 8; ++i) { const int n = n0 + 8 * wave + i;
            const float zf = lane < 33 ? hy_feat(n, lane) : 0.f;
            float a = b1[lane];
            for (int k = 0; k < 33; ++k) a += __shfl(zf, k) * w1[k * 64 + lane];
            float hh = sinf(fr * a);
            a = b2[lane];
            for (int k = 0; k < 64; ++k) a += __shfl(hh, k) * w2[k * 64 + lane];
            hh = sinf(fr * a);
            a = b2[64 + lane];
            for (int k = 0; k < 64; ++k) a += __shfl(hh, k) * w2[4096 + k * 64 + lane];
            h3[i] = sinf(fr * a); }
#pragma unroll 1
        for (int mh = 0; mh < 4; ++mh) {
            float acc[4][8];
#pragma unroll
            for (int m = 0; m < 4; ++m)
#pragma unroll
                for (int i = 0; i < 8; ++i) acc[m][i] = 0.f;
            for (int k = 0; k < 64; ++k) { float wv[4];
#pragma unroll
                for (int m = 0; m < 4; ++m) wv[m] = w3[(size_t)k * 1024 + mh * 256 + m * 64 + lane];
#pragma unroll
                for (int i = 0; i < 8; ++i) { const float hv = __shfl(h3[i], k);
#pragma unroll
                    for (int m = 0; m < 4; ++m) acc[m][i] += hv * wv[m]; } }
#pragma unroll
            for (int m = 0; m < 4; ++m) { const int c = m * 64 + lane; const float mind = -3.0701134573253944f, maxd = -15.350567286626972f; const float ad = fabsf(mind + (float)c * ((maxd - mind) / 255.0f));
#pragma unroll
                for (int i = 0; i < 8; ++i) { const int n = n0 + 8 * wave + i; const float tn = (float)n / (float)(SEQ_ - 1); TL[(mh * 256 + c) * 66 + 8 * wave + i] = (unsigned short)f2bf(acc[m][i] * expf(-tn * ad)); } }
        }
        __syncthreads();
        for (int i = tix; i < 1024 * 64; i += 512) { const int col = i >> 6, p = i & 63, od = col >> 8, c = col & 255, o = od >> 1, d = od & 1, n = n0 + p;
            if (d == 0 || n >= 1) { const int y = d == 0 ? SEQ_ - 1 - n : SEQ_ - 1 + n; RF2[((size_t)l * 512 + o * 256 + c) * RFL + 129 + y] = TL[col * 66 + p]; } }
        __syncthreads();
    }
}
__device__ __forceinline__ void split8(const f32x4& x0, const f32x4& x1, sbf16x8& hi, sbf16x8& lo) {
    v4u h, l;
    h.x = cvtpk(x0[0], x0[1]); l.x = cvtpk(x0[0] - bfl(h.x), x0[1] - bfh(h.x)); h.y = cvtpk(x0[2], x0[3]); l.y = cvtpk(x0[2] - bfl(h.y), x0[3] - bfh(h.y));
    h.z = cvtpk(x1[0], x1[1]); l.z = cvtpk(x1[0] - bfl(h.z), x1[1] - bfh(h.z)); h.w = cvtpk(x1[2], x1[3]); l.w = cvtpk(x1[2] - bfl(h.w), x1[3] - bfh(h.w));
    hi = __builtin_bit_cast(sbf16x8, h); lo = __builtin_bit_cast(sbf16x8, l);
}
__device__ __forceinline__ void ew_hy_filter2(LAS unsigned char* lds, const float* w1a, const float* b1a, const float* fqa, const float* w2a, const float* b2a, const float* w3a, pt* RF2,
                                              const float* x, const float* lng, const float* lnb, pt* HBo, int wv_) {
    const int tix = opaque_tid(), lane = tix & 63, wave = tix >> 6, r = lane & 15, g4 = lane >> 4;
    const int gw = wave * gridDim.x + blockIdx.x, NGW = gridDim.x * 8; int lrow = gw; f32x4 nx[2][4];
    LAS float* GBL = (LAS float*)(lds + 1024 * 66 * 2 + 64 * 68 * 4);
    for (int i = tix; i < 2048; i += 512) GBL[i] = i < 1024 ? lng[i] : lnb[i - 1024];
    __syncthreads();
#pragma unroll
    for (int u = 0; u < 2; ++u) if (gw + u * NGW < T) {
#pragma unroll
        for (int j = 0; j < 4; ++j) nx[u][j] = *(const f32x4*)(x + (size_t)(gw + u * NGW) * DM + 256 * j + 4 * lane); }
#define LN_STEP2() do { _Pragma("unroll") for (int u = 0; u < 2; ++u) { const int row = lrow + u * NGW; if (row < T) { f32x4 v[4]; \
            _Pragma("unroll") for (int j = 0; j < 4; ++j) v[j] = nx[u][j]; \
            if (row + 2 * NGW < T) { _Pragma("unroll") for (int j = 0; j < 4; ++j) nx[u][j] = *(const f32x4*)(x + (size_t)(row + 2 * NGW) * DM + 256 * j + 4 * lane); } \
            ln_finish_l(v, GBL, nullptr, HBo + (size_t)row * DM, lane); } } lrow += 2 * NGW; } while (0)
    LAS unsigned short* TL = (LAS unsigned short*)lds;
    LAS float* H3 = (LAS float*)(lds + 1024 * 66 * 2);
    for (int i = blockIdx.x * 512 + tix; i < 1024 * 385; i += gridDim.x * 512) { const int rw = i / 385, j = i % 385; const int idx = j < 129 ? j : (2 * SEQ_ - 1) + j; RF2[(size_t)rw * RFL + idx] = 0; }
    for (int tile = blockIdx.x; tile < 2 * (SEQ_ / 64); tile += gridDim.x) {
        const int l = tile / (SEQ_ / 64), n0 = (tile % (SEQ_ / 64)) * 64;
        const float* w3 = w3a + (size_t)l * 64 * 1024;
        { const float* w1 = w1a + l * 33 * 64; const float* w2 = w2a + l * 2 * 4096;
          const float fr = fqa[l * 64 + lane];
          { const float bb1 = b1a[l * 64 + lane]; float wr[33];
#pragma unroll
            for (int k = 0; k < 33; ++k) wr[k] = w1[k * 64 + lane];
#pragma unroll 1
            for (int i = 0; i < 8; ++i) { const int n = n0 + 8 * wave + i;
                const float zf = lane < 33 ? hy_feat(n, lane) : 0.f;
                float a0 = bb1, a1 = 0.f;
#pragma unroll
                for (int k = 0; k < 33; ++k) { if (k & 1) a1 += rdlane(zf, k) * wr[k]; else a0 += rdlane(zf, k) * wr[k]; }
                H3[(8 * wave + i) * 68 + lane] = __sinf(fr * (a0 + a1));
                if ((i & 3) == 3) LN_STEP2(); } }
#pragma unroll 1
          for (int j = 0; j < 2; ++j) { const float bb = b2a[l * 128 + j * 64 + lane]; float wr[64];
#pragma unroll
            for (int k = 0; k < 64; ++k) wr[k] = w2[j * 4096 + k * 64 + lane];
#pragma unroll 1
            for (int i = 0; i < 8; ++i) { const float hh = H3[(8 * wave + i) * 68 + lane];
                float a0 = bb, a1 = 0.f;
#pragma unroll
                for (int k = 0; k < 64; ++k) { if (k & 1) a1 += rdlane(hh, k) * wr[k]; else a0 += rdlane(hh, k) * wr[k]; }
                H3[(8 * wave + i) * 68 + lane] = __sinf(fr * (a0 + a1));
                if ((i & 3) == 3) LN_STEP2(); } } }
        __syncthreads();
        { sbf16x8 Ah[4][2], Al[4][2];
#pragma unroll
          for (int mt = 0; mt < 4; ++mt)
#pragma unroll
              for (int ks = 0; ks < 2; ++ks) { const LAS float* hp = H3 + (16 * mt + r) * 68 + 32 * ks + 8 * g4; const f32x4 x0 = *(const LAS f32x4*)hp, x1 = *(const LAS f32x4*)(hp + 4); split8(x0, x1, Ah[mt][ks], Al[mt][ks]); }
#pragma unroll
          for (int nt = 0; nt < 8; ++nt) {
              const int col = 128 * wave + 16 * nt + r; sbf16x8 Bh[2], Bl[2];
#pragma unroll
              for (int ks = 0; ks < 2; ++ks) { f32x4 x0, x1;
#pragma unroll
                  for (int j = 0; j < 4; ++j) { x0[j] = w3[(size_t)(32 * ks + 8 * g4 + j) * 1024 + col]; x1[j] = w3[(size_t)(32 * ks + 8 * g4 + 4 + j) * 1024 + col]; }
                  split8(x0, x1, Bh[ks], Bl[ks]); }
              const int c = col & 255; const float mind = -3.0701134573253944f, maxd = -15.350567286626972f; const float ad = fabsf(mind + (float)c * ((maxd - mind) / 255.0f));
#pragma unroll
              for (int mt = 0; mt < 4; ++mt) { f32x4 acc = {0.f, 0.f, 0.f, 0.f};
#pragma unroll
                  for (int ks = 0; ks < 2; ++ks) { acc = __builtin_amdgcn_mfma_f32_16x16x32_bf16(Al[mt][ks], Bh[ks], acc, 0, 0, 0); acc = __builtin_amdgcn_mfma_f32_16x16x32_bf16(Ah[mt][ks], Bl[ks], acc, 0, 0, 0);
                      acc = __builtin_amdgcn_mfma_f32_16x16x32_bf16(Ah[mt][ks], Bh[ks], acc, 0, 0, 0); }
                  float v[4];
#pragma unroll
                  for (int i = 0; i < 4; ++i) { const int n = n0 + 16 * mt + 4 * g4 + i; const float tn = (float)n / (float)(SEQ_ - 1); v[i] = acc[i] * __expf(-tn * ad); }
                  LAS unsigned* tp = (LAS unsigned*)(TL + col * 66 + 16 * mt + 4 * g4); tp[0] = cvtpk(v[0], v[1]); tp[1] = cvtpk(v[2], v[3]); }
              if ((nt & 3) == 3) LN_STEP2(); } }
        __syncthreads();
        for (int i = tix; i < 1024 * 64; i += 512) { const int col = i >> 6, p = i & 63, od = col >> 8, c = col & 255, o = od >> 1, d = od & 1, n = n0 + p;
            if (d == 0 || n >= 1) { const int y = d == 0 ? SEQ_ - 1 - n : SEQ_ - 1 + n; RF2[((size_t)l * 512 + o * 256 + c) * RFL + 129 + y] = TL[col * 66 + p]; } }
        __syncthreads();
    }
    while (lrow < T) LN_STEP2();
#undef LN_STEP2
}
__device__ __forceinline__ void ew_hy_norm(const pt* RF2, float* INVN2, int wv_) {
    const int tix = opaque_tid(), lane = tix & 63; const int gw = (tix >> 6) * gridDim.x + blockIdx.x, NGW = gridDim.x * 8;
    for (int rw = gw; rw < 1024; rw += NGW) { const v4u* p = (const v4u*)(RF2 + (size_t)rw * RFL); float s = 0.f;
        constexpr int NV = (RFL / 8 + 63) / 64; v4u vv[NV];
#pragma unroll
        for (int i = 0; i < NV; ++i) { const int ix = lane + 64 * i; vv[i] = ix < RFL / 8 ? p[ix] : (v4u){0u, 0u, 0u, 0u}; }
#pragma unroll
        for (int i = 0; i < NV; ++i)
#pragma unroll
            for (int e = 0; e < 4; ++e) s += fabsf(bfl(vv[i][e])) + fabsf(bfh(vv[i][e]));
        s = wsum(s); if (lane == 0) INVN2[rw] = 1.0f / fmaxf(s, 1e-12f); }
}

__device__ __forceinline__ void transpose_item(const float* src, int ld_src, pt* dst, int ld_dst, LAS float* scr, int lane) {
#pragma unroll 8
    for (int i = 0; i < 32; ++i) { const int kk = 2 * i + (lane >> 5); scr[kk * 33 + (lane & 31)] = src[(size_t)kk * ld_src + (lane & 31)]; }
    asm volatile("s_waitcnt lgkmcnt(0)" ::: "memory");
    const int c = lane & 7;
#pragma unroll
    for (int j = 0; j < 4; ++j) { const int n = (lane >> 3) + 8 * j; const LAS float* s = scr + (8 * c) * 33 + n;
        v4u o; o.x = f2bf(s[0]) | (f2bf(s[33]) << 16); o.y = f2bf(s[66]) | (f2bf(s[99]) << 16); o.z = f2bf(s[132]) | (f2bf(s[165]) << 16); o.w = f2bf(s[198]) | (f2bf(s[231]) << 16);
        *(v4u*)(dst + (size_t)n * ld_dst + 8 * c) = o; }
    asm volatile("s_waitcnt lgkmcnt(0)" ::: "memory");
}
__device__ __forceinline__ void convert_weights(const MP& p, int l, LAS unsigned char* lds, int which  , int wv_, int vb = -1, int vn = 0) {
    const int tix = opaque_tid(); const int lane = tix & 63, wave = tix >> 6;
    LAS float* scr = (LAS float*)(lds + wave * 16384);
    if (vb < 0) { vb = blockIdx.x; vn = gridDim.x; }
    const int gw = wave * vn + vb, NGW = vn * 8;
    char* ws = p.ws;
    pt* WinT = (pt*)(ws + OFF_WIN); pt* WoT = (pt*)(ws + OFF_WO); pt* WguT = (pt*)(ws + OFF_WGU); pt* WdT = (pt*)(ws + OFF_WD);
    const float* w_in = p.in[3] + (size_t)l * DM * DIN; const float* w_out = p.in[18] + (size_t)l * DM * DM;
    const float* wg = p.in[25] + (size_t)l * 16 * DM * 512; const float* wu = p.in[26] + (size_t)l * 16 * DM * 512; const float* wd = p.in[27] + (size_t)l * 16 * 512 * DM;
    constexpr int I_IN = 16 * (DIN / 32), I_O = 16 * 32, I_GU = 16 * 2 * 16 * 16, I_D = 16 * 8 * 32, NIT = I_IN + I_O + I_GU + I_D;
    for (int it = gw; it < NIT; it += NGW) {
        int r = it;
        if (r < I_IN ? !(which & 1) : (r < I_IN + I_O ? !(which & 2) : !(which & 4))) continue;
        if (r < I_IN) { const int kb = r / (DIN / 32), nb = r % (DIN / 32); transpose_item(w_in + (size_t)kb * 64 * DIN + oldcol(nb * 32), DIN, WinT + (size_t)nb * 32 * DM + kb * 64, DM, scr, lane); continue; } r -= I_IN;
        if (r < I_O) { const int kb = r / 32, nb = r % 32; transpose_item(w_out + (size_t)kb * 64 * DM + nb * 32, DM, WoT + (size_t)nb * 32 * DM + kb * 64, DM, scr, lane); continue; } r -= I_O;
        if (r < I_GU) { const int e = r / 512, hf = (r / 256) & 1, kb = (r / 16) & 15, nb = r & 15; const float* s = (hf ? wu : wg) + (size_t)e * DM * 512 + (size_t)kb * 64 * 512 + nb * 32;
            transpose_item(s, 512, WguT + (size_t)e * 1024 * 1024 + (size_t)((nb >> 2) * 256 + hf * 128 + (nb & 3) * 32) * 1024 + kb * 64, 1024, scr, lane); continue; } r -= I_GU;
        { const int e = r / 256, kb = (r / 32) & 7, nb = r & 31; transpose_item(wd + (size_t)e * 512 * DM + (size_t)kb * 64 * DM + nb * 32, DM, WdT + (size_t)e * 1024 * 512 + (size_t)nb * 32 * 512 + kb * 64, 512, scr, lane); }
    }
    if (which & 1) { v4u z = {0u, 0u, 0u, 0u}; v4u* zp = (v4u*)(WinT + (size_t)DIN * DM); const size_t nz = (size_t)(NP - DIN) * DM * 2 / 16;
      for (size_t i = (size_t)vb * 512 + tix; i < nz; i += (size_t)vn * 512) zp[i] = z; }
}
#endif

#define GS_LOOP(N) for (size_t id = gtid; id < (size_t)(N); id += gstride)
template <int S> __device__ __forceinline__ void run_stage(const MP& p, int l, void* ldsv, int wv_) {
#ifdef CPU_EMU
    const unsigned tix = threadIdx.x;
#else
    const unsigned tix = (unsigned)opaque_tid();
#endif
    const size_t gtid = ((size_t)(tix >> 6) * gridDim.x + blockIdx.x) * 64 + (tix & 63);
    const size_t gstride = (size_t)gridDim.x * blockDim.x;
    const float *x = p.in[0], *ln_in_g = p.in[1], *ln_in_b = p.in[2], *w_in = p.in[3], *gla_wa2 = p.in[4], *gla_ba = p.in[5], *gla_norm_g = p.in[6], *hg_lb_logits = p.in[7],
                *hg_norm_g = p.in[8], *hy_conv_w = p.in[9], *hy_conv_b = p.in[10], *hy_w1 = p.in[11], *hy_b1 = p.in[12], *hy_freq = p.in[13], *hy_w2 = p.in[14], *hy_b2 = p.in[15],
                *hy_w3 = p.in[16], *hy_bias = p.in[17], *w_out = p.in[18], *ln1_g = p.in[19], *ln1_b = p.in[20], *moe_wr_g = p.in[21], *moe_br_g = p.in[22], *moe_wr_e = p.in[23],
                *moe_br_e = p.in[24], *moe_w_gate = p.in[25], *moe_w_up = p.in[26], *moe_w_down = p.in[27], *ln2_g = p.in[28], *ln2_b = p.in[29];
    float* H = p.out; char* ws = p.ws;
    pt* PROJ = (pt*)(ws + OFF_PROJ); pt* XB = (pt*)(ws + OFF_XB); pt* MIXIN = XB; pt* U2 = (pt*)(ws + OFF_U2); pt* Z1 = (pt*)(ws + OFF_Z1); pt* AL = (pt*)(ws + OFF_AL);
    float* HF = (float*)(ws + OFF_HF); float* HA = (float*)(ws + OFF_HA); float* HB = (float*)(ws + OFF_HB); float* INVN = (float*)(ws + OFF_INVN); float* LB = (float*)(ws + OFF_LB);
    int* RE = (int*)(ws + OFF_RE); float* RW = (float*)(ws + OFF_RW); float* MIX = (float*)(ws + OFF_MIX); pt* HID = (pt*)(ws + OFF_HID); pt* Y = (pt*)(ws + OFF_Y); pt* XS = (pt*)(ws + OFF_XS);
#if OPT_EW && !defined(CPU_EMU)
#define EWG 1
    pt* RFs = (pt*)(ws + OFF_RF) + (size_t)l * 512 * RFL; INVN += l * 512;
#else
#define EWG 0
    pt* RFs = (pt*)(ws + OFF_RF);
#endif
    pt* YT = (pt*)(ws + OFF_YT);
    int* SLOT = (int*)(ws + OFF_SLOT); int* CNT = (int*)(ws + OFF_CNT); int* CUR = CNT + 16;
    (void)w_in; (void)w_out; (void)ldsv;
    if constexpr (S < 0) {
        GS_LOOP(768) d_k_lb(hg_lb_logits, LB, id);
#if EWG
        ew_ln_in(x, ln_in_g, ln_in_b, H, XB, wv_);
        ew_hy_filter((LAS unsigned char*)ldsv, hy_w1, hy_b1, hy_freq, hy_w2, hy_b2, hy_w3, (pt*)(ws + OFF_RF), wv_);
#else
        GS_LOOP(T) d_k_ln(x, nullptr, 1.0f, ln_in_g, ln_in_b, H, XB, id);
#endif
    }
    if constexpr (S == 0) {
#if OPT_GEMM && !defined(CPU_EMU)
        convert_weights(p, l, (LAS unsigned char*)ldsv, 7, wv_);
#endif
#if EWG
        if (l == 0) ew_hy_norm((const pt*)(ws + OFF_RF), (float*)(ws + OFF_INVN), wv_);
#else
        GS_LOOP(L * 64) d_k_hy_mlp1(hy_w1 + l * 33 * 64, hy_b1 + l * 64, hy_freq + l * 64, HA, id);
#endif
        if (gtid < 32) CNT[gtid] = 0;
    }
    if constexpr (S == 1) {
#if OPT_GEMM && !defined(CPU_EMU)
        { SchedStatic Sc; Sc.init(XB, ws + OFF_WIN, T, NP, DM, gridDim.x, blockIdx.x); pg8::Gemm g{(const pg8::bf16_t*)XB, (const pg8::bf16_t*)(ws + OFF_WIN), T, NP, DM, DM};
          EpiBf16Store E{PROJ, NP}; pg8::gemm_phase<EpiBf16Store, SchedStatic, true, true>((LAS unsigned char*)ldsv, g, Sc, E, wv_); }
#else
        GS_LOOP((size_t)(T / 4) * DIN) d_k_inproj(H, w_in + (size_t)l * DM * DIN, PROJ, id);
#endif
#if !EWG
        GS_LOOP(L * 64) d_k_hy_mlp2(HA, hy_w2 + (l * 2 + 0) * 4096, hy_b2 + (l * 2 + 0) * 64, hy_freq + l * 64, HB, id);
#endif
    }
    if constexpr (S == 2) {
        GS_LOOP(L * 64) d_k_hy_mlp2(HB, hy_w2 + (l * 2 + 1) * 4096, hy_b2 + (l * 2 + 1) * 64, hy_freq + l * 64, HA, id);
#if !(OPT_SCAN && !defined(CPU_EMU))
        GS_LOOP((size_t)2 * T * 192) d_k_gla_alogit(PROJ, gla_wa2 + l * 2 * 16 * 192, gla_ba + l * 2 * 192, AL, id);
#endif
    }
#if OPT_SCAN && !defined(CPU_EMU)
    const ScanP spg{PROJ, gla_wa2 + l * 2 * 16 * 192, gla_ba + l * 2 * 192, LB + l * 768, (pt*)(ws + OFF_DSG), (float*)(ws + OFF_DDG), MIXIN, gla_norm_g + l * 384, (pt*)(ws + OFF_AL), DM};
    const ScanP sph{PROJ, gla_wa2, gla_ba, LB + l * 768, (pt*)(ws + OFF_DSH), (float*)(ws + OFF_DDH), MIXIN, hg_norm_g + l * 384, (pt*)(ws + OFF_AL), DM};
#endif
    if constexpr (S == 3) {
#if OPT_SCAN && !defined(CPU_EMU)
        scan_p1<1>((LAS unsigned char*)ldsv, sph, wv_); scan_p1<0>((LAS unsigned char*)ldsv, spg, wv_);
#endif
#if !EWG
        GS_LOOP(L * 1024) d_k_hy_filt(HA, hy_w3 + (size_t)l * 64 * 1024, HF, id);
#endif
    }
    if constexpr (S == 4) {
#if OPT_SCAN && !defined(CPU_EMU)
        GS_LOOP((size_t)NB * 12 * 1536) scan_p2(spg.DS, spg.DD, sph.DS, sph.DD, id);
#endif
#if !EWG
        GS_LOOP(512) d_k_hy_norm(HF, INVN, id);
        GS_LOOP((size_t)512 * RFL) d_k_hy_rf(HF, RFs, id);
#endif
    }
    if constexpr (S == 5) {
#if OPT_SCAN && !defined(CPU_EMU)
        scan_p3<1>((LAS unsigned char*)ldsv, sph, wv_); scan_p3<0>((LAS unsigned char*)ldsv, spg, wv_);
#else
        GS_LOOP(NB * 6 * 64) d_k_scan_hg(PROJ, LB + l * 768, MIXIN, id);
        GS_LOOP(NB * 6 * 64) d_k_scan_gla(PROJ, AL, MIXIN, id);
#endif
    }
    if constexpr (S == 6) {
#if EWG
        ew_hy_prep((LAS unsigned char*)ldsv, PROJ, hy_conv_w + l * 3 * 768, hy_conv_b + l * 768, U2, wv_);
#else
        GS_LOOP((size_t)T * 768) d_k_hy_prep(PROJ, hy_conv_w + l * 3 * 768, hy_conv_b + l * 768, U2, id);
#endif
#if !(OPT_SCAN && !defined(CPU_EMU))
        GS_LOOP(T * 12) d_k_headnorm(PROJ, gla_norm_g + l * 384, hg_norm_g + l * 384, MIXIN, id);
#endif
    }
    if constexpr (S == 7) {
#if OPT_HY && !defined(CPU_EMU)
        hy_conv_mfma((LAS unsigned char*)ldsv, U2, 768, U2 + (size_t)256 * L, 768, RFs, INVN, hy_bias + (l * 2 + 0) * 256, Z1, 256, wv_);
#else
        GS_LOOP((size_t)T * 256) d_k_hy_conv_cm(U2, 768, U2 + (size_t)256 * L, 768, RFs, INVN, hy_bias + (l * 2 + 0) * 256, Z1, 256, id);
#endif
    }
    if constexpr (S == 8) {
#if OPT_HY && !defined(CPU_EMU)
        hy_conv_mfma((LAS unsigned char*)ldsv, Z1, 256, U2 + (size_t)512 * L, 768, RFs + (size_t)256 * RFL, INVN + 256, hy_bias + (l * 2 + 1) * 256, YT, 256, wv_);
#else
        GS_LOOP((size_t)T * 256) d_k_hy_conv_cm(Z1, 256, U2 + (size_t)512 * L, 768, RFs + (size_t)256 * RFL, INVN + 256, hy_bias + (l * 2 + 1) * 256, YT, 256, id);
#endif
    }
    if constexpr (S == 9) {
#if EWG
        ew_hy_tr((LAS unsigned char*)ldsv, YT, MIXIN, DM, wv_);
#else
        GS_LOOP((size_t)T * 256) d_k_hy_tr(YT, MIXIN, id);
#endif
    }
    if constexpr (S == 10) {
#if OPT_GEMM && !defined(CPU_EMU)
        { SchedStatic Sc; Sc.init(MIXIN, ws + OFF_WO, T, DM, DM, gridDim.x, blockIdx.x); pg8::Gemm g{(const pg8::bf16_t*)MIXIN, (const pg8::bf16_t*)(ws + OFF_WO), T, DM, DM, DM};
          EpiF32Store E{MIX, DM}; pg8::gemm_phase<EpiF32Store, SchedStatic, true, true>((LAS unsigned char*)ldsv, g, Sc, E, wv_); }
#else
        GS_LOOP((size_t)(T / 4) * DM) d_k_outproj(MIXIN, w_out + (size_t)l * DM * DM, MIX, id);
#endif
    }
    if constexpr (S == 11) {
#if EWG
        ew_ln1_route<false>((LAS unsigned char*)ldsv, H, H, MIX, ln1_g + l * DM, ln1_b + l * DM, XB, moe_wr_g + l * DM * 4, moe_br_g + l * 4, moe_wr_e + l * DM * 16, moe_br_e + l * 16, RE, RW, CNT, wv_);
#else
        GS_LOOP(T) d_k_ln(H, MIX, ALPHA, ln1_g + l * DM, ln1_b + l * DM, H, XB, id);
#endif
    }
    if constexpr (S == 12) {
        GS_LOOP(T) d_k_route(H, moe_wr_g + l * DM * 4, moe_br_g + l * 4, moe_wr_e + l * DM * 16, moe_br_e + l * 16, RE, RW, CNT, id);
    }
    if constexpr (S == 13) {
        GS_LOOP(T) d_k_moe_assign(RE, CNT, CUR, SLOT, id);
    }
    if constexpr (S == 14) {
#if EWG
        ew_assign_gather((LAS unsigned char*)ldsv, RE, CNT, CUR, SLOT, XB, XS, wv_);
#else
        GS_LOOP((size_t)T * 2 * DM) d_k_moe_gather(XB, SLOT, XS, id);
#endif
    }
    if constexpr (S == 15) {
#if OPT_MOE && !defined(CPU_EMU)
        { SchedMoE Sc; Sc.init(XS, ws + OFF_WGU, DM, CNT, (size_t)1024 * 1024 * 2, gridDim.x, blockIdx.x); pg8::Gemm g{(const pg8::bf16_t*)XS, (const pg8::bf16_t*)(ws + OFF_WGU), NSLOT, 1024, DM, DM};
          EpiSiluMul E{HID}; pg8::gemm_phase<EpiSiluMul, SchedMoE, true, true>((LAS unsigned char*)ldsv, g, Sc, E, wv_); }
#else
        GS_LOOP((size_t)NSLOT * 512) d_k_moe_hid2(XS, CNT, moe_w_gate + (size_t)l * 16 * DM * 512, moe_w_up + (size_t)l * 16 * DM * 512, HID, id);
#endif
    }
    if constexpr (S == 16) {
#if OPT_MOE && !defined(CPU_EMU)
        { SchedMoE Sc; Sc.init(HID, ws + OFF_WD, 512, CNT, (size_t)1024 * 512 * 2, gridDim.x, blockIdx.x); pg8::Gemm g{(const pg8::bf16_t*)HID, (const pg8::bf16_t*)(ws + OFF_WD), NSLOT, 1024, 512, 512};
          EpiBf16Store E{Y, DM}; pg8::gemm_phase<EpiBf16Store, SchedMoE, true, true>((LAS unsigned char*)ldsv, g, Sc, E, wv_); }
#else
        GS_LOOP((size_t)NSLOT * DM) d_k_moe_down2(HID, CNT, moe_w_down + (size_t)l * 16 * 512 * DM, Y, id);
#endif
    }
    if constexpr (S == 17) {
#if EWG
        ew_ln2(H, H, Y, SLOT, RW, ln2_g + l * DM, ln2_b + l * DM, XB, wv_);
#else
        GS_LOOP(T) d_k_ln2(H, Y, SLOT, RW, ALPHA, ln2_g + l * DM, ln2_b + l * DM, H, XB, id);
#endif
    }
}


#ifndef CPU_EMU
constexpr size_t G_INVN = al256c(OFF_WEND), G_LB = al256c(G_INVN + 1024 * 4), G_RE = al256c(G_LB + 2 * 768 * 4), G_RW = al256c(G_RE + (size_t)T * 8), G_SLOT = al256c(G_RW + (size_t)T * 8), G_CNT = al256c(G_SLOT + (size_t)T * 8),
                 G_TOKR = al256c(G_CNT + 256), G_BAR = al256c(G_TOKR + (size_t)NSLOT * 4), G_DDG = al256c(G_BAR + 3456 * 4), G_DDH = al256c(G_DDG + (size_t)NB * 12 * (L / 64) * 32 * 4), G_PROJ = al256c(G_DDH + (size_t)NB * 12 * (L / 64) * 64 * 4),
                 G_XB = al256c(G_PROJ + (size_t)T * NPS * 2), G_DSH = al256c(G_XB + (size_t)T * DM * 2), G_DSG = al256c(G_DSH + (size_t)NB * 12 * (L / 64) * 64 * 64 * 2), G_AL = al256c(G_DSG + (size_t)NB * 12 * (L / 64) * 64 * 32 * 2),
                 G_RF = al256c(G_AL + (size_t)2 * T * 192 * 2), G_END = al256c(G_RF + (size_t)1024 * RFL * 2);
constexpr size_t G_Z1 = OFF_WGU, G_YT = OFF_WGU + (size_t)T * 256 * 2, G_U2 = G_XB, G_MIXB = G_XB, G_XS = G_PROJ, G_Y = G_PROJ, G_HID = al256c(G_XS + (size_t)NSLOT * DM * 2);
static_assert(G_END <= 512 * MiB && G_HID + (size_t)NSLOT * 512 * 2 <= G_XB && (size_t)T * 512 * 2 <= (size_t)16 * 1024 * 1024 * 2 && (size_t)T * 768 * 2 <= (size_t)T * DM * 2, "fused workspace map");
constexpr int NGS = 11;
template <int S> __device__ __forceinline__ void gstage(const MP& p, int l, void* ldsv, int wv_) {
    const unsigned tix = (unsigned)make_tid(wv_);
    int bid = blockIdx.x; asm volatile("" : "+s"(bid));
    const size_t gtid = ((size_t)(tix >> 6) * gridDim.x + blockIdx.x) * 64 + (tix & 63);
    const size_t gstride = (size_t)gridDim.x * 512;
    char* ws = p.ws; LAS unsigned char* lds = (LAS unsigned char*)ldsv;
    pt* HB = (pt*)p.out;
    pt* HB1 = (l + 1 < DEPTH) ? HB : (pt*)(ws + G_XB);
    pt* PROJ = (pt*)(ws + G_PROJ); pt* XB = (pt*)(ws + G_XB); pt* U2 = (pt*)(ws + G_U2); pt* Z1 = (pt*)((char*)p.out + (size_t)T * DM * 2); pt* YT = Z1 + (size_t)T * 256; pt* MIXB = (pt*)(ws + G_MIXB);
    pt* RFs = (pt*)(ws + G_RF) + (size_t)l * 512 * RFL; float* INVN = (float*)(ws + G_INVN) + l * 512; float* LB = (float*)(ws + G_LB);
    int* RE = (int*)(ws + G_RE); float* RW = (float*)(ws + G_RW); int* SLOT = (int*)(ws + G_SLOT); int* CNT = (int*)(ws + G_CNT); int* CUR = CNT + 16; int* TOKR = (int*)(ws + G_TOKR);
    pt* XS = (pt*)(ws + G_XS); pt* HID = (pt*)(ws + G_HID); pt* Y = (pt*)(ws + G_Y);
    const ScanP spg{PROJ, p.in[4] + l * 2 * 16 * 192, p.in[5] + l * 2 * 192, LB + l * 768, (pt*)(ws + G_DSG), (float*)(ws + G_DDG), PROJ, p.in[6] + l * 384, (pt*)(ws + G_AL), NPS};
    const ScanP sph{PROJ, p.in[4], p.in[5], LB + l * 768, (pt*)(ws + G_DSH), (float*)(ws + G_DDH), PROJ, p.in[8] + l * 384, (pt*)(ws + G_AL), NPS};
    if constexpr (S < 0) {
        GS_LOOP(768) d_k_lb(p.in[7], LB, id);
        if (gtid < 32) CNT[gtid] = 0;
        convert_weights(p, 0, lds, 1, wv_);
        __syncthreads();
        ew_hy_filter2(lds, p.in[11], p.in[12], p.in[13], p.in[14], p.in[15], p.in[16], (pt*)(ws + G_RF), p.in[0], p.in[1], p.in[2], HB, wv_);
    }
    if constexpr (S == 0) {
        SchedStatic Sc; Sc.init(HB, ws + OFF_WIN, T, NP, DM, gridDim.x, bid); pg8::Gemm g{(const pg8::bf16_t*)HB, (const pg8::bf16_t*)(ws + OFF_WIN), T, NP, DM, DM};
        EpiProjAct E{PROJ, NPS, LB + l * 768}; pg8::gemm_phase<EpiProjAct, SchedStatic, true, true>(lds, g, Sc, E, wv_);
        if (l == 0) ew_hy_norm((const pt*)(ws + G_RF), (float*)(ws + G_INVN), wv_);
    }
    if constexpr (S == 1) {
        scan_p1<1>(lds, sph, wv_); scan_p1<0>(lds, spg, wv_);
        ew_hy_prep(lds, PROJ, p.in[9] + l * 3 * 768, p.in[10] + l * 768, U2, wv_);
    }
    if constexpr (S == 2) {
        const int nwv = (int)gridDim.x * 8;
        if ((P2_NT + nwv - 1) / nwv <= 64) {
            const P2Side ps = p2_side_init(spg.DS, spg.DD, sph.DS, sph.DD, wv_ * (int)gridDim.x + bid, nwv, (int)(tix & 63));
            hy_conv_mfma<2>(lds, U2, 768, U2 + (size_t)256 * L, 768, RFs, INVN, p.in[17] + (l * 2 + 0) * 256, Z1, 256, wv_, MoeCvt(), ps);
        } else { GS_LOOP((size_t)NB * 12 * 1536) scan_p2(spg.DS, spg.DD, sph.DS, sph.DD, id);
            hy_conv_mfma(lds, U2, 768, U2 + (size_t)256 * L, 768, RFs, INVN, p.in[17] + (l * 2 + 0) * 256, Z1, 256, wv_); }
    }
    if constexpr (S == 3) {
        scan_p3<1>(lds, sph, wv_); scan_p3<0>(lds, spg, wv_);
        MoeCvt mc{p.in[25] + (size_t)l * 16 * DM * 512, (long)((const char*)p.in[26] - (const char*)p.in[25]), p.in[27] + (size_t)l * 16 * 512 * DM, (pt*)(ws + OFF_WGU), (pt*)(ws + OFF_WD), min(wv_ * (int)gridDim.x + bid, MC_NIT - 1), (int)gridDim.x * 8};
        hy_conv_mfma<1>(lds, Z1, 256, U2 + (size_t)512 * L, 768, RFs + (size_t)256 * RFL, INVN + 256, p.in[17] + (l * 2 + 1) * 256, YT, 256, wv_, mc);
    }
    if constexpr (S == 4) {
        ew_hy_tr(lds, YT, PROJ, NPS, wv_);
        convert_weights(p, l, lds, 2, wv_);
    }
    if constexpr (S == 5) {
        SchedStatic Sc; Sc.init(PROJ, ws + OFF_WO, T, DM, DM, gridDim.x, bid, NPS); pg8::Gemm g{(const pg8::bf16_t*)PROJ, (const pg8::bf16_t*)(ws + OFF_WO), T, DM, DM, NPS};
        EpiBf16Store E{MIXB, DM}; pg8::gemm_phase<EpiBf16Store, SchedStatic, true, true>(lds, g, Sc, E, wv_);
    }
    if constexpr (S == 6) { GS_LOOP(NSLOT) TOKR[id] = 0; }
    if constexpr (S == 6) ew_ln1_route<true, true>(lds, HB, nullptr, MIXB, p.in[19] + l * DM, p.in[20] + l * DM, HB1, p.in[21] + l * DM * 4, p.in[22] + l * 4, p.in[23] + l * DM * 16, p.in[24] + l * 16, RE, RW, CNT, wv_);
    if constexpr (S == 7) ew_assign_gather(lds, RE, CNT, CUR, SLOT, HB1, XS, wv_, TOKR);
    if constexpr (S == 8) { SchedMoE Sc; Sc.init(HB1, ws + OFF_WGU, DM, CNT, (size_t)1024 * 1024 * 2, gridDim.x, bid, TOKR); pg8::Gemm g{(const pg8::bf16_t*)HB1, (const pg8::bf16_t*)(ws + OFF_WGU), NSLOT, 1024, DM, DM};
        EpiSiluMul E{HID}; pg8::gemm_phase<EpiSiluMul, SchedMoE, true, true, true>(lds, g, Sc, E, wv_);
        if (l + 1 < DEPTH) {
            const int G = gridDim.x, nun = Sc.ntiles * 4, rounds = (nun + G - 1) / G, nlast = nun - (rounds - 1) * G, nidle = G - nlast;
            if (nidle >= 64) { if (bid >= nlast) convert_weights(p, l + 1, lds, 1, wv_, bid - nlast, nidle); } else convert_weights(p, l + 1, lds, 1, wv_); } }
    if constexpr (S == 9) { SchedMoE Sc; Sc.init(HID, ws + OFF_WD, 512, CNT, (size_t)1024 * 512 * 2, gridDim.x, bid); pg8::Gemm g{(const pg8::bf16_t*)HID, (const pg8::bf16_t*)(ws + OFF_WD), NSLOT, 1024, 512, 512};
        EpiBf16Store E{Y, DM}; pg8::gemm_phase<EpiBf16Store, SchedMoE, true, true>(lds, g, Sc, E, wv_); }
    if constexpr (S == 10) {
        if (l + 1 < DEPTH) ew_ln2<true>(HB1, nullptr, Y, SLOT, RW, p.in[28] + l * DM, p.in[29] + l * DM, HB, wv_);
        else ew_ln2<true>(HB1, p.out, Y, SLOT, RW, p.in[28] + l * DM, p.in[29] + l * DM, nullptr, wv_);
        __syncthreads();
        if (gtid < 32) CNT[gtid] = 0;
    }
}
#endif
#ifdef CPU_EMU
#define GRID_SYNC()
#define LDSPTR nullptr
#define MEGA_DECL __global__ void mega(MP p, int ph_lo, int ph_hi)
#define MEGA_PRE const int wv_ = 0;
#else
#define GRID_SYNC() xcd_barrier(xbar, wv_)
#define LDSPTR ((void*)lds)
#define MEGA_DECL __global__ void __launch_bounds__(512) mega(MP p, int ph_lo, int ph_hi)
#define MEGA_PRE extern __shared__ __attribute__((aligned(16))) unsigned char lds[]; cg::grid_group grid = cg::this_grid(); if (ph_hi < 0) grid.sync(); \
    const int wv_ = __builtin_amdgcn_readfirstlane((int)(threadIdx.x >> 6)); \
    volatile LAS unsigned* xst = (volatile LAS unsigned*)((LAS unsigned char*)lds + LDS_BYTES - 64); { const int t_ = make_tid(wv_); if (t_ < 4) xst[t_] = 0u; } __syncthreads(); \
    const XcdBarrier xbar = xcd_barrier_post((unsigned*)(p.ws + G_BAR), xst, make_tid(wv_) == 0);
#endif
#define STAGE(SS) do { const int ph_ = 1 + l * NPL + (SS); if (ph_ >= ph_lo && ph_ < ph_hi) { if ((PROBE_MASK >> (SS)) & 1) { run_stage<SS>(p, l, LDSPTR, wv_); GRID_SYNC(); } run_stage<SS>(p, l, LDSPTR, wv_); if (ph_ + 1 < ph_hi) GRID_SYNC(); } } while (0)
MEGA_DECL {
    MEGA_PRE
#ifdef CPU_EMU
    if (ph_lo <= 0 && 0 < ph_hi) { run_stage<-1>(p, 0, LDSPTR, wv_); if (1 < ph_hi) GRID_SYNC(); }
#pragma unroll 1
    for (int l = 0; l < DEPTH; ++l) {
        STAGE(0); STAGE(1); STAGE(2); STAGE(3); STAGE(4); STAGE(5); STAGE(6); STAGE(7); STAGE(8); STAGE(9); STAGE(10); STAGE(11); STAGE(12); STAGE(13); STAGE(14); STAGE(15); STAGE(16); STAGE(17);
    }
#else
#define GSTAGE(SS) do { if ((PROBE_MASK >> (SS)) & 1) { gstage<SS>(p, l, LDSPTR, wv_); GRID_SYNC(); } gstage<SS>(p, l, LDSPTR, wv_); if (!((SS) == NGS - 1 && l == DEPTH - 1)) GRID_SYNC(); } while (0)
    gstage<-1>(p, 0, LDSPTR, wv_); GRID_SYNC();
#pragma unroll 1
    for (int l = 0; l < DEPTH; ++l) {
        GSTAGE(0); GSTAGE(1); GSTAGE(2); GSTAGE(3); GSTAGE(4); GSTAGE(5); GSTAGE(6); GSTAGE(7); GSTAGE(8); GSTAGE(9); GSTAGE(10);
    }
#endif
}

extern "C" void kernel_launch(void* const* d_in, const int* in_sizes, int n_in, void* d_out, int out_size, void* d_ws, size_t ws_size, hipStream_t stream) {
#ifdef CPU_EMU
    if (n_in != 30 || ws_size < WS_NEED || out_size != T * DM) return;
#else
    if (n_in != 30 || ws_size < G_END || out_size != T * DM) return;
#endif
    MP p{};
    for (int i = 0; i < 30; ++i) p.in[i] = (const float*)d_in[i];
    p.out = (float*)d_out; p.ws = (char*)d_ws;
#ifdef CPU_EMU
    for (int ph = 0; ph < NPH; ++ph) { cpu_launch(8, 512, [&] { mega(p, ph, ph + 1); }); }
#else
    static int grid_blocks = 0;
    if (!grid_blocks) {
        int dev = 0, cus = 0, per_cu = 0;
        (void)hipGetDevice(&dev);
        (void)hipDeviceGetAttribute(&cus, hipDeviceAttributeMultiprocessorCount, dev);
        (void)hipFuncSetAttribute((const void*)mega, hipFuncAttributeMaxDynamicSharedMemorySize, LDS_BYTES);
        (void)hipOccupancyMaxActiveBlocksPerMultiprocessor(&per_cu, mega, 512, LDS_BYTES);
        if (per_cu < 1) per_cu = 1;
        grid_blocks = cus * per_cu;
    }
    int lo = 0, hi = NPH;
    void* args[] = {&p, &lo, &hi};
    (void)hipMemsetAsync((char*)d_ws + G_BAR, 0, 3456 * 4, stream);
    hipError_t e = hipLaunchCooperativeKernel((void*)mega, dim3(grid_blocks), dim3(512), args, LDS_BYTES, stream);
    if (e != hipSuccess) fprintf(stderr, "cooperative launch failed: %s (grid %d)\n", hipGetErrorString(e), grid_blocks);
#endif
}
```

```cpp
#ifndef CPU_EMU
#include <hip/hip_runtime.h>
#include <hip/hip_cooperative_groups.h>
#include <cstdio>
namespace cg = cooperative_groups;
#endif
#include <cstdint>
#include <cstddef>
#include <type_traits>

#ifndef SEQ_
#define SEQ_ 8192
#endif
#ifndef BATCH_
#define BATCH_ 4
#endif
#ifndef OPT_GEMM
#define OPT_GEMM 1
#endif
#ifndef OPT_MOE
#define OPT_MOE 1
#endif
#ifndef OPT_HY
#define OPT_HY 1
#endif
#ifndef OPT_SCAN
#define OPT_SCAN 1
#endif
#ifndef OPT_EW
#define OPT_EW 1
#endif
#ifndef PROBE_MASK
#define PROBE_MASK 0
#endif
constexpr int DM = 1024, NB = BATCH_, L = SEQ_, T = NB * L, DEPTH = 2, DIN = 3872, NP = 4096;
#ifdef CPU_EMU
constexpr int NPS = NP;
#else
constexpr int NPS = NP;
#endif
constexpr int C_GV = 0, C_HI = 384, C_HY = 768, C_GQ = 1536, C_GK = 1728, C_GG = 1920, C_HQ = 2304, C_HF = 2688, C_HGT = 3456, C_GA = 3840;
__host__ __device__ __forceinline__ int oldcol(int n) {
    return n < 384 ? 384 + n : n < 768 ? 2336 + (n - 384) : n < 1536 ? 3104 + (n - 768) : n < 1728 ? (n - 1536) : n < 1920 ? 192 + (n - 1728) : n < 2304 ? 768 + (n - 1920)
         : n < 2688 ? 1184 + (n - 2304) : n < 3456 ? 1568 + (n - 2688) : n < 3840 ? 2720 + (n - 3456) : 1152 + (n - 3840);
}
constexpr float ALPHA = 1.41421356237f, LN_EPS = 1e-5f, RMS_EPS = 1e-6f;

#ifdef CPU_EMU
typedef float pt;
__device__ __forceinline__ float ldp(const pt* p) { return *p; }
__device__ __forceinline__ void stp(pt* p, float v) { *p = v; }
#define FEXP(x) expf(x)
#define FDIV(a, b) ((a) / (b))
#else
typedef unsigned short pt;
__device__ __forceinline__ float ldp(const pt* p) { return __uint_as_float(((unsigned)*p) << 16); }
__device__ __forceinline__ unsigned f2bf(float v) { unsigned u = __float_as_uint(v); return (u + 0x7fffu + ((u >> 16) & 1u)) >> 16; }
__device__ __forceinline__ void stp(pt* p, float v) { *p = (pt)f2bf(v); }
#define FEXP(x) __expf(x)
#define FDIV(a, b) __fdividef(a, b)
#endif
__device__ __forceinline__ float sigmoidf_(float x) { return FDIV(1.0f, 1.0f + FEXP(-x)); }
__device__ __forceinline__ float siluf_(float x) { return FDIV(x, 1.0f + FEXP(-x)); }
__device__ __forceinline__ float logsigmoidf_(float x) { return fminf(x, 0.f) - log1pf(expf(-fabsf(x))); }

__device__ __forceinline__ void d_k_ln(const float* a, const float* b, float alpha, const float* g, const float* be, float* out, pt* xb, size_t id_) {
    int r = (int)id_;
    const float* ar = a + (size_t)r * DM; const float* br = b ? b + (size_t)r * DM : nullptr;
    float s = 0.f;
    for (int i = 0; i < DM; ++i) s += alpha * ar[i] + (br ? br[i] : 0.f);
    float mean = s / DM, q = 0.f;
    for (int i = 0; i < DM; ++i) { float d = alpha * ar[i] + (br ? br[i] : 0.f) - mean; q += d * d; }
    float rstd = 1.0f / sqrtf(q / DM + LN_EPS);
    float* o = out + (size_t)r * DM; pt* ob = xb + (size_t)r * DM;
    for (int i = 0; i < DM; ++i) { float v = alpha * ar[i] + (br ? br[i] : 0.f); float y = (v - mean) * rstd * g[i] + be[i]; o[i] = y; stp(ob + i, y); }
}
__device__ __forceinline__ void d_k_inproj(const float* A, const float* B, pt* C, size_t id_) {
    int n = (int)(id_ % (size_t)DIN); int m0 = (int)(id_ / (size_t)DIN) * 4; int oc = oldcol(n);
    float c0 = 0, c1 = 0, c2 = 0, c3 = 0; const float* a = A + (size_t)m0 * DM;
    for (int k = 0; k < DM; ++k) { float bb = B[(size_t)k * DIN + oc]; c0 += a[k] * bb; c1 += a[DM + k] * bb; c2 += a[2 * DM + k] * bb; c3 += a[3 * DM + k] * bb; }
    stp(C + (size_t)m0 * NPS + n, c0); stp(C + (size_t)(m0 + 1) * NPS + n, c1); stp(C + (size_t)(m0 + 2) * NPS + n, c2); stp(C + (size_t)(m0 + 3) * NPS + n, c3);
}
__device__ __forceinline__ void d_k_outproj(const pt* A, const float* B, float* C, size_t id_) {
    int n = (int)(id_ % (size_t)DM); int m0 = (int)(id_ / (size_t)DM) * 4;
    float c0 = 0, c1 = 0, c2 = 0, c3 = 0; const pt* a = A + (size_t)m0 * DM;
    for (int k = 0; k < DM; ++k) { float bb = B[(size_t)k * DM + n]; c0 += ldp(a + k) * bb; c1 += ldp(a + DM + k) * bb; c2 += ldp(a + 2 * DM + k) * bb; c3 += ldp(a + 3 * DM + k) * bb; }
    C[(size_t)m0 * DM + n] = c0; C[(size_t)(m0 + 1) * DM + n] = c1; C[(size_t)(m0 + 2) * DM + n] = c2; C[(size_t)(m0 + 3) * DM + n] = c3;
}
__device__ __forceinline__ void d_k_lb(const float* logits, float* lb, size_t id_) {
    int i = (int)id_;
    float a = logits[i], b = logits[768 + i], m = fmaxf(a, b), ea = expf(a - m), eb = expf(b - m);
    float p0 = ea / (ea + eb), p1 = eb / (ea + eb);
    lb[i] = p0 - p0; lb[768 + i] = (p0 + p1) - p0;
}
__device__ __forceinline__ void d_k_gla_alogit(const pt* proj, const float* wa2, const float* ba, pt* AL, size_t id_) {
    size_t idx = (size_t)id_;
    int j = idx % 192; size_t r = idx / 192; int t = r % T, d = r / T;
    float a = ba[d * 192 + j];
    for (int rr = 0; rr < 16; ++rr) a += ldp(proj + (size_t)t * NPS + C_GA + d * 16 + rr) * wa2[(d * 16 + rr) * 192 + j];
    stp(AL + idx, logsigmoidf_(a) * (1.0f / 16.0f));
}
__device__ __forceinline__ void d_k_scan_gla(const pt* proj, const pt* AL, pt* mixin, size_t id_) {
    int id = (int)id_;
    int v = id & 63, h = (id >> 6) % 6, b = id / 384;
    const float qs = 0.17677669529663687f;
    for (int dir = 0; dir < 2; ++dir) {
        float S[32];
#pragma unroll
        for (int k = 0; k < 32; ++k) S[k] = 0.f;
        for (int i = 0; i < L; ++i) {
            int t = dir ? L - 1 - i : i; size_t row = (size_t)b * L + t; const pt* pr = proj + row * NPS;
            float vv = ldp(pr + C_GV + h * 64 + v), o = 0.f;
            const pt* al = AL + ((size_t)dir * T + row) * 192 + h * 32;
#pragma unroll
            for (int k = 0; k < 32; ++k) {
                float a = FEXP(ldp(al + k));
                S[k] = a * S[k] + ldp(pr + C_GK + h * 32 + k) * vv;
                o += ldp(pr + C_GQ + h * 32 + k) * qs * S[k];
            }
            pt* op = mixin + row * DM + h * 64 + v;
            if (dir == 0) stp(op, o); else stp(op, ldp(op) + o);
        }
    }
}
__device__ __forceinline__ void d_k_scan_hg(const pt* proj, const float* lb  , pt* mixin, size_t id_) {
    int id = (int)id_;
    int v = id & 63, h = (id >> 6) % 6, b = id / 384;
    for (int dir = 0; dir < 2; ++dir) {
        float S[64];
#pragma unroll
        for (int k = 0; k < 64; ++k) S[k] = 0.f;
        for (int i = 0; i < L; ++i) {
            int t = dir ? L - 1 - i : i; size_t row = (size_t)b * L + t; const pt* pr = proj + row * NPS;
            float vv = ldp(pr + C_HI + h * 64 + v), o = 0.f;
#pragma unroll
            for (int k = 0; k < 64; ++k) {
                float z = ldp(pr + C_HF + dir * 384 + h * 64 + k), l_ = lb[dir * 384 + h * 64 + k];
                float sg = sigmoidf_(z), a = l_ + (1.f - l_) * sg, kk = (1.f - l_) * (1.f - sg);
                S[k] = a * S[k] + kk * vv;
                o += siluf_(ldp(pr + C_HQ + h * 64 + k)) * S[k];
            }
            pt* op = mixin + row * DM + 384 + h * 64 + v;
            if (dir == 0) stp(op, o); else stp(op, ldp(op) + o);
        }
    }
}
__device__ __forceinline__ void d_k_headnorm(const pt* proj, const float* gla_g, const float* hg_g, pt* mixin, size_t id_) {
    int id = (int)id_;
    int hh = id % 12, t = id / 12; pt* o = mixin + (size_t)t * DM + hh * 64;
    float q = 0.f; for (int j = 0; j < 64; ++j) { float v = ldp(o + j); q += v * v; }
    float r = 1.0f / sqrtf(q / 64.f + RMS_EPS);
    for (int j = 0; j < 64; ++j) {
        float gate, g;
        if (hh < 6) { gate = siluf_(ldp(proj + (size_t)t * NPS + C_GG + hh * 64 + j)); g = gla_g[hh * 64 + j]; }
        else { gate = sigmoidf_(ldp(proj + (size_t)t * NPS + C_HGT + (hh - 6) * 64 + j)); g = hg_g[(hh - 6) * 64 + j]; }
        stp(o + j, ldp(o + j) * r * g * gate);
    }
}
__device__ __forceinline__ float hy_feat(int n, int i) {
    if (i == 0) return (float)n / (float)(L - 1);
    float w = 6.283185307179586f * (float)n / (float)L;
    int bi = (i - 1) & 15; float band = 1e-4f + (float)bi * ((15.0f - 1e-4f) / 15.0f);
    return (i <= 16) ? cosf(band * w) : -sinf(band * w);
}
__device__ __forceinline__ void d_k_hy_mlp1(const float* w1, const float* b1, const float* freq, float* hout, size_t id_) {
    int id = (int)id_;
    int j = id & 63, n = id >> 6; float a = b1[j];
    for (int i = 0; i < 33; ++i) a += hy_feat(n, i) * w1[i * 64 + j];
    hout[id] = sinf(freq[j] * a);
}
__device__ __forceinline__ void d_k_hy_mlp2(const float* hin, const float* w2, const float* b2, const float* freq, float* hout, size_t id_) {
    int id = (int)id_;
    int j = id & 63, n = id >> 6; float a = b2[j];
    for (int i = 0; i < 64; ++i) a += hin[n * 64 + i] * w2[i * 64 + j];
    hout[id] = sinf(freq[j] * a);
}
__device__ __forceinline__ void d_k_hy_filt(const float* hin, const float* w3, float* HF, size_t id_) {
    int id = (int)id_;
    int col = id & 1023, n = id >> 10, c = col & 255, od = col >> 8;
    float a = 0.f;
    for (int i = 0; i < 64; ++i) a += hin[n * 64 + i] * w3[i * 1024 + col];
    const float mind = -3.0701134573253944f, maxd = -15.350567286626972f;
    float delta = mind + (float)c * ((maxd - mind) / 255.0f);
    float tn = (float)n / (float)(L - 1);
    HF[((size_t)od * L + n) * 256 + c] = a * expf(-tn * fabsf(delta));
}
__device__ __forceinline__ void d_k_hy_norm(const float* HF, float* invn, size_t id_) {
    int id = (int)id_;
    int c = id & 255, o = id >> 8; float s = 0.f;
    for (int n = 0; n < L; ++n) s += fabsf(HF[((size_t)(o * 2 + 0) * L + n) * 256 + c]);
    for (int n = 1; n < L; ++n) s += fabsf(HF[((size_t)(o * 2 + 1) * L + n) * 256 + c]);
    invn[id] = 1.0f / fmaxf(s, 1e-12f);
}
__device__ __forceinline__ void d_k_hy_short(const pt* proj, const float* cw, const float* cb, pt* u2, size_t id_) {
    size_t id = (size_t)id_;
    int c = id % 768; size_t row = id / 768; int t = row % L;
    float a = cb[c];
    for (int j = 0; j < 3; ++j) { int tt = t + j - 1; if (tt >= 0 && tt < L) a += cw[j * 768 + c] * ldp(proj + (row + j - 1) * NPS + C_HY + c); }
    stp(u2 + id, a);
}
__device__ __forceinline__ void d_k_hy_conv(const pt* z, int zs, const pt* gate, int gs, const float* HFo  , const float* invn, const float* bias, pt* out, int os, size_t id_) {
    size_t id = (size_t)id_;
    int c = id & 255; size_t row = id >> 8; int t = row % L; size_t r0 = row - t;
    float a = 0.f;
    for (int s = 0; s <= t; ++s) a += HFo[(size_t)(t - s) * 256 + c] * ldp(z + (r0 + s) * zs + c);
    for (int s = t + 1; s < L; ++s) a += HFo[((size_t)L + (s - t)) * 256 + c] * ldp(z + (r0 + s) * zs + c);
    float zc = ldp(z + row * zs + c);
    stp(out + row * os + c, ldp(gate + row * gs + c) * (a * invn[c] + zc * bias[c]));
}
__device__ __forceinline__ void d_k_route(const float* h, const float* wrg, const float* brg, const float* wre, const float* bre, int* E, float* W, int* CNT, size_t id_) {
    int t = (int)id_;
    const float* x = h + (size_t)t * DM;
    float lg0 = brg[0], lg1 = brg[1], lg2 = brg[2], lg3 = brg[3];
    for (int i = 0; i < DM; ++i) { float xi = x[i]; lg0 += xi * wrg[i * 4]; lg1 += xi * wrg[i * 4 + 1]; lg2 += xi * wrg[i * 4 + 2]; lg3 += xi * wrg[i * 4 + 3]; }
    int gi = 0; float gm = lg0;
    if (lg1 > gm) { gm = lg1; gi = 1; } if (lg2 > gm) { gm = lg2; gi = 2; } if (lg3 > gm) { gm = lg3; gi = 3; }
    float sg = expf(lg0 - gm) + expf(lg1 - gm) + expf(lg2 - gm) + expf(lg3 - gm);
    float gval = 1.0f / sg;
    float le0 = bre[gi * 4], le1 = bre[gi * 4 + 1], le2 = bre[gi * 4 + 2], le3 = bre[gi * 4 + 3];
    for (int i = 0; i < DM; ++i) { float xi = x[i]; const float* w = wre + i * 16 + gi * 4; le0 += xi * w[0]; le1 += xi * w[1]; le2 += xi * w[2]; le3 += xi * w[3]; }
    int e0 = 0; float v0 = le0;
    if (le1 > v0) { v0 = le1; e0 = 1; } if (le2 > v0) { v0 = le2; e0 = 2; } if (le3 > v0) { v0 = le3; e0 = 3; }
    int e1 = -1; float v1 = -3.0e38f;
    if (e0 != 0 && le0 > v1) { v1 = le0; e1 = 0; } if (e0 != 1 && le1 > v1) { v1 = le1; e1 = 1; }
    if (e0 != 2 && le2 > v1) { v1 = le2; e1 = 2; } if (e0 != 3 && le3 > v1) { v1 = le3; e1 = 3; }
    float p1 = expf(v1 - v0);
    float w0 = 1.0f / (1.0f + p1), w1 = p1 / (1.0f + p1);
    E[t * 2] = gi * 4 + e0; E[t * 2 + 1] = gi * 4 + e1; W[t * 2] = gval * w0; W[t * 2 + 1] = gval * w1;
    atomicAdd(CNT + gi * 4 + e0, 1); atomicAdd(CNT + gi * 4 + e1, 1);
}
__device__ __forceinline__ void d_k_moe_hid(const float* h, const int* E, const float* wg, const float* wu, float* hid, size_t id_) {
    size_t id = (size_t)id_;
    int j = id & 511; size_t a = id >> 9; int t = a >> 1; int e = E[a];
    const float* x = h + (size_t)t * DM; const float* g = wg + (size_t)e * DM * 512 + j; const float* u = wu + (size_t)e * DM * 512 + j;
    float sg = 0.f, su = 0.f;
    for (int i = 0; i < DM; ++i) { sg += x[i] * g[(size_t)i * 512]; su += x[i] * u[(size_t)i * 512]; }
    hid[id] = siluf_(sg) * su;
}
__device__ __forceinline__ void d_k_moe_down(const float* hid, const int* E, const float* W, const float* wd, float* y, size_t id_) {
    size_t id = (size_t)id_;
    int n = id & 1023; int t = id >> 10; float acc = 0.f;
    for (int kk = 0; kk < 2; ++kk) {
        int e = E[t * 2 + kk]; const float* hrow = hid + ((size_t)t * 2 + kk) * 512; const float* w = wd + (size_t)e * 512 * DM + n;
        float s = 0.f; for (int j = 0; j < 512; ++j) s += hrow[j] * w[(size_t)j * DM];
        acc += W[t * 2 + kk] * s;
    }
    y[id] = acc;
}


constexpr int RFL = 2 * L + 384;
__device__ __forceinline__ void d_k_hy_prep(const pt* proj, const float* cw, const float* cb, pt* u2t, size_t id_) {
    size_t id = (size_t)id_; int t = (int)(id % L); size_t bc = id / L; int c = (int)(bc % 768); size_t b = bc / 768; size_t row = b * L + t;
    float a = cb[c];
    for (int j = 0; j < 3; ++j) { int tt = t + j - 1; if (tt >= 0 && tt < L) a += cw[j * 768 + c] * ldp(proj + (row + j - 1) * NPS + C_HY + c); }
    stp(u2t + id, a);
}
__device__ __forceinline__ void d_k_hy_rf(const float* HF, pt* RFs, size_t id_) {
    size_t id = (size_t)id_; int idx = (int)(id % RFL); int oc = (int)(id / RFL); int c = oc & 255, o = oc >> 8; int y = idx - 129;
    float v = 0.f;
    if (y >= 0 && y <= L - 1) v = HF[((size_t)(o * 2 + 0) * L + (L - 1 - y)) * 256 + c];
    else if (y >= L && y <= 2 * L - 2) v = HF[((size_t)(o * 2 + 1) * L + (y - L + 1)) * 256 + c];
    stp(RFs + id, v);
}
__device__ __forceinline__ void d_k_hy_conv_cm(const pt* z  , int zc, const pt* gate, int gc, const pt* RFo  , const float* invn, const float* bias, pt* out, int oc_, size_t id_) {
    size_t id = (size_t)id_; int t = (int)(id % L); int bc = (int)(id / L); int c = bc & 255, b = bc >> 8;
    const pt* zr = z + ((size_t)b * zc + c) * L; const pt* rf = RFo + (size_t)c * RFL + 129 + (L - 1 - t);
    float a = 0.f;
    for (int s = 0; s < L; ++s) a += ldp(rf + s) * ldp(zr + s);
    stp(out + ((size_t)b * oc_ + c) * L + t, ldp(gate + ((size_t)b * gc + c) * L + t) * (a * invn[c] + ldp(zr + t) * bias[c]));
}
__device__ __forceinline__ void d_k_hy_tr(const pt* yt, pt* mixin, size_t id_) {
    size_t id = (size_t)id_; int c = id & 255; size_t row = id >> 8; size_t b = row / L; int t = (int)(row % L);
    mixin[row * DM + 768 + c] = yt[(b * 256 + c) * L + t];
}

constexpr int NSLOT = (2 * T + 16 * 255) / 256 * 256 + 256;
__device__ __forceinline__ void moe_tables(const int* CNT, int* pstart  ) {
    int acc = 0;
    for (int e = 0; e < 16; ++e) { pstart[e] = acc; acc += (CNT[e] + 255) / 256 * 256; }
    pstart[16] = acc;
}
__device__ __forceinline__ int moe_expert_of_row(const int* pstart, int row) { int e = 0; for (int i = 1; i < 16; ++i) if (row >= pstart[i]) e = i; return e; }
__device__ __forceinline__ void d_k_moe_hid2(const pt* XS, const int* CNT, const float* wg, const float* wu, pt* hid, size_t id_) {
    int ps[17]; moe_tables(CNT, ps);
    size_t id = (size_t)id_; int j = id & 511; int r = (int)(id >> 9); if (r >= ps[16]) return;
    int e = moe_expert_of_row(ps, r);
    const pt* x = XS + (size_t)r * DM; const float* g = wg + (size_t)e * DM * 512 + j; const float* u = wu + (size_t)e * DM * 512 + j;
    float sg = 0.f, su = 0.f;
    for (int i = 0; i < DM; ++i) { float xi = ldp(x + i); sg += xi * g[(size_t)i * 512]; su += xi * u[(size_t)i * 512]; }
    stp(hid + id, siluf_(sg) * su);
}
__device__ __forceinline__ void d_k_moe_down2(const pt* hid, const int* CNT, const float* wd, pt* y, size_t id_) {
    int ps[17]; moe_tables(CNT, ps);
    size_t id = (size_t)id_; int n = id & 1023; int r = (int)(id >> 10); if (r >= ps[16]) return;
    int e = moe_expert_of_row(ps, r);
    const pt* hrow = hid + (size_t)r * 512; const float* w = wd + (size_t)e * 512 * DM + n;
    float sacc = 0.f; for (int j = 0; j < 512; ++j) sacc += ldp(hrow + j) * w[(size_t)j * DM];
    stp(y + id, sacc);
}
__device__ __forceinline__ void d_k_ln2(const float* a, const pt* Y, const int* SLOT, const float* W, float alpha, const float* g, const float* be, float* out, pt* xb, size_t id_) {
    int r = (int)id_;
    const float* ar = a + (size_t)r * DM; const pt* y0 = Y + (size_t)SLOT[2 * r] * DM; const pt* y1 = Y + (size_t)SLOT[2 * r + 1] * DM; const float w0 = W[2 * r], w1 = W[2 * r + 1];
    float s = 0.f;
    for (int i = 0; i < DM; ++i) s += alpha * ar[i] + (w0 * ldp(y0 + i) + w1 * ldp(y1 + i));
    float mean = s / DM, q = 0.f;
    for (int i = 0; i < DM; ++i) { float d = alpha * ar[i] + (w0 * ldp(y0 + i) + w1 * ldp(y1 + i)) - mean; q += d * d; }
    float rstd = 1.0f / sqrtf(q / DM + LN_EPS);
    float* o = out + (size_t)r * DM; pt* ob = xb + (size_t)r * DM;
    for (int i = 0; i < DM; ++i) { float v = alpha * ar[i] + (w0 * ldp(y0 + i) + w1 * ldp(y1 + i)); float yy = (v - mean) * rstd * g[i] + be[i]; o[i] = yy; stp(ob + i, yy); }
}
__device__ __forceinline__ void d_k_moe_assign(const int* E, const int* CNT, int* CUR, int* SLOT, size_t id_) {
    int t = (int)id_; int ps[17]; moe_tables(CNT, ps);
#pragma unroll
    for (int k = 0; k < 2; ++k) { int e = E[2 * t + k]; int base = 0;
#pragma unroll
        for (int i = 0; i < 16; ++i) if (i == e) base = ps[i];
        SLOT[2 * t + k] = base + atomicAdd(CUR + e, 1); }
}
__device__ __forceinline__ void d_k_moe_gather(const pt* XB, const int* SLOT, pt* XS, size_t id_) {
    size_t id = (size_t)id_; int i = id & 1023; int a = (int)(id >> 10); int t = a >> 1;
    XS[(size_t)SLOT[a] * DM + i] = XB[(size_t)t * DM + i];
}

static inline constexpr size_t al256c(size_t x) { return (x + 255) & ~(size_t)255; }
constexpr size_t MiB = (size_t)1 << 20;
constexpr size_t OFF_WIN = 0, OFF_WO = OFF_WIN + (size_t)NP * DM * 2, OFF_WGU = OFF_WO + (size_t)DM * DM * 2, OFF_WD = OFF_WGU + (size_t)16 * 1024 * 1024 * 2, OFF_WEND = OFF_WD + (size_t)16 * 1024 * 512 * 2;
#if defined(CPU_EMU)
constexpr size_t OFF_HA = al256c(OFF_WEND);
constexpr size_t OFF_HB = al256c(OFF_HA + (size_t)L * 64 * 4);
constexpr size_t OFF_INVN = al256c(OFF_HB + (size_t)L * 64 * 4);
#else
constexpr size_t OFF_HA = 0, OFF_HB = 0;
constexpr size_t OFF_INVN = al256c(OFF_WEND);
#endif
constexpr size_t OFF_LB = al256c(OFF_INVN + 1024 * 4);
constexpr size_t OFF_RE = al256c(OFF_LB + 2 * 768 * 4);
constexpr size_t OFF_RW = al256c(OFF_RE + (size_t)T * 2 * 4);
constexpr size_t OFF_SLOT = al256c(OFF_RW + (size_t)T * 2 * 4);
constexpr size_t OFF_CNT = al256c(OFF_SLOT + (size_t)T * 2 * 4);
constexpr size_t OFF_BAR = al256c(OFF_CNT + 256);
constexpr size_t OFF_DDG = al256c(OFF_BAR + 3456 * 4);
constexpr size_t OFF_DDH = al256c(OFF_DDG + (size_t)NB * 12 * (L / 64) * 32 * 4);
constexpr size_t OFF_PROJ = al256c(OFF_DDH + (size_t)NB * 12 * (L / 64) * 64 * 4);
constexpr size_t OFF_XB = al256c(OFF_PROJ + (size_t)T * NP * sizeof(pt));
constexpr size_t OFF_U2 = al256c(OFF_XB + (size_t)T * DM * sizeof(pt));
constexpr size_t OFF_RF = al256c(OFF_U2 + (size_t)T * 768 * sizeof(pt));
constexpr size_t OFF_Z1 = al256c(OFF_RF + (size_t)1024 * RFL * sizeof(pt));
constexpr size_t OFF_YT = al256c(OFF_Z1 + (size_t)T * 256 * sizeof(pt));
constexpr size_t OFF_AL = al256c(OFF_Z1 + (size_t)NB * 12 * (L / 64) * 64 * 32 * 2);
#ifdef CPU_EMU
constexpr size_t OFF_HF = al256c(OFF_AL + (size_t)2 * T * 192 * sizeof(pt) + (size_t)T * 512 * sizeof(pt));
constexpr size_t WS_NEED = al256c(OFF_HF + (size_t)4 * L * 256 * 4);
constexpr size_t OFF_XS = WS_NEED;
#else
constexpr size_t OFF_HF = OFF_XB;
constexpr size_t WS_NEED = al256c(OFF_AL + (size_t)2 * T * 192 * sizeof(pt));
constexpr size_t OFF_XS = OFF_PROJ;
static_assert(OFF_AL >= OFF_YT + 0 && OFF_AL + (size_t)2 * T * 192 * 2 >= OFF_YT + (size_t)T * 256 * 2, "AL sits behind the GLA states and covers the tail of the span");
#endif
constexpr size_t OFF_DSH = OFF_U2, OFF_DSG = OFF_Z1;
constexpr size_t OFF_MIX = OFF_PROJ, OFF_Y = OFF_XS, OFF_HID = al256c(OFF_XS + (size_t)NSLOT * DM * sizeof(pt));
#ifndef CPU_EMU
static_assert(OFF_HID + (size_t)NSLOT * 512 * sizeof(pt) <= OFF_XB, "MoE overlay must stay inside PROJ");
static_assert((size_t)NB * 12 * (L / 64) * 64 * 64 * 2 <= (size_t)T * 768 * 2 && (size_t)NB * 12 * (L / 64) * 64 * 32 * 2 <= (size_t)T * 512 * 2, "scan state overlays");
static_assert(WS_NEED <= 512 * MiB, "workspace");
#endif
constexpr int NPL = 18, NPH = 1 + DEPTH * NPL;
constexpr int LDS_BYTES = 163840;

struct MP { const float* in[30]; float* out; char* ws; };

#ifndef CPU_EMU
__device__ __forceinline__ int make_tid(int wv) { int t; asm volatile("v_mbcnt_lo_u32_b32 %0, -1, 0\n\tv_mbcnt_hi_u32_b32 %0, -1, %0" : "=v"(t)); return (wv << 6) | t; }
#define opaque_tid() make_tid(wv_)
namespace pg8 {
#define PG8_LAS __attribute__((address_space(3)))
typedef unsigned short bf16_t;
typedef short bf16x8 __attribute__((ext_vector_type(8)));
typedef float f32x4 __attribute__((ext_vector_type(4)));
typedef unsigned u32x4 __attribute__((ext_vector_type(4)));
constexpr int BM = 256, BK = 64, HALF = 128, HTB = HALF * BK * 2  , STAGE_BYTES = 8 * HTB, NXCD = 8, WGM = 8;

__host__ __device__ __forceinline__ int lds_byte(int r, int c) { const int st = (r >> 4) * 2 + (c >> 5), rr = r & 15, cc = c & 31, ob = rr * 64 + cc * 2; return st * 1024 + (ob ^ (((ob >> 9) & 1) << 5)); }
__host__ __device__ __forceinline__ void stage_rc(int b, int& R, int& C) { const int st = b / 1024, sb = b % 1024, swz = sb ^ (((sb >> 9) & 1) << 5); R = (st >> 1) * 16 + swz / 64; C = (st & 1) * 32 + (swz % 64) / 2; }
__host__ __device__ __forceinline__ int perm32(int rho) { const int n = rho >> 4, i = rho & 15; return 8 * (i >> 2) + 4 * n + (i & 3); }

struct Unit { int pm, pn; const char* a; const char* b; const int* rows; };
struct Gemm { const bf16_t* A; const bf16_t* Bt; int M, N, K, lda; };
__device__ __forceinline__ unsigned cvt_pk_bf16(float lo, float hi) { unsigned r; asm volatile("v_cvt_pk_bf16_f32 %0, %1, %2" : "=v"(r) : "v"(lo), "v"(hi)); return r; }
template <class Epi, class Sched, bool ALIGN_EPI = false, bool SP2 = false, bool GATHER = false>
__device__ __forceinline__ void gemm_phase(PG8_LAS unsigned char* lds, const Gemm g, const Sched& S, const Epi& E, int wv_) {
    const int tid = opaque_tid(), wid = __builtin_amdgcn_readfirstlane(tid >> 6), lane = tid & 63, wr = wid >> 2, wc = wid & 3, fr = lane & 15, fq = lane >> 4;
    const int K = g.K, nt = K / BK;
    unsigned voffA[2], voffB[2];
#pragma unroll
    for (int i = 0; i < 2; ++i) { int R, C; stage_rc(tid * 16 + i * 8192, R, C); const int Rb = Epi::PERM ? ((R & ~31) + perm32(R & 31)) : R;
        voffA[i] = (unsigned)(R * g.lda + C) * 2u; voffB[i] = (unsigned)(Rb * K + C) * 2u; }
    const size_t kstep = (size_t)(BK * 2);
    const size_t hstepA = GATHER ? (size_t)0 : (size_t)HALF * g.lda * 2, hstepB = (size_t)HALF * K * 2;
    unsigned oc[2][2] = {{0u, 0u}, {0u, 0u}};
#define PG8_GOFF(dst, rows_) do { _Pragma("unroll") for (int i_ = 0; i_ < 2; ++i_) { int R_, C_; stage_rc(opaque_tid() * 16 + i_ * 8192, R_, C_); _Pragma("unroll") for (int h_ = 0; h_ < 2; ++h_) \
        dst[h_][i_] = (unsigned)*(const int*)((const char*)(rows_) + ((unsigned)R_ * 4u + 512u * h_)) * (unsigned)(g.lda * 2) + (unsigned)C_ * 2u; } } while (0)
    const unsigned ldsw = (unsigned)wid * 1024u;
    const int aoff = lds_byte(wr * 64 + fr, fq * 8), boff = lds_byte(wc * 32 + fr, fq * 8);
#define PG8_SA(b, h) (((b) * 2 + (h)) * HTB)
#define PG8_SB(b, h) ((4 + (b) * 2 + (h)) * HTB)
#define PG8_STAGE(bufoff, gbase, voff) do { _Pragma("unroll") for (int _i = 0; _i < 2; ++_i) \
        __builtin_amdgcn_global_load_lds((const unsigned*)((const char*)(gbase) + (voff)[_i]), (PG8_LAS unsigned*)(lds + (bufoff) + ldsw + _i * 8192), 16, 0, 0); } while (0)
#define PG8_LDA(dst, b, h) do { _Pragma("unroll") for (int m = 0; m < 4; ++m) _Pragma("unroll") for (int k = 0; k < 2; ++k) dst[m][k] = *(const PG8_LAS bf16x8*)(lds + PG8_SA(b, h) + aoff + m * 2048 + k * 1024); } while (0)
#define PG8_LDB(dst, b, h) do { _Pragma("unroll") for (int n = 0; n < 2; ++n) _Pragma("unroll") for (int k = 0; k < 2; ++k) dst[n][k] = *(const PG8_LAS bf16x8*)(lds + PG8_SB(b, h) + boff + n * 2048 + k * 1024); } while (0)
#define PG8_MMA(ai, bj, At, Bt) do { __builtin_amdgcn_s_setprio(1); _Pragma("unroll") for (int m = 0; m < 4; ++m) _Pragma("unroll") for (int n = 0; n < 2; ++n) _Pragma("unroll") for (int k = 0; k < 2; ++k) \
        acc[ai][bj][m][n] = __builtin_amdgcn_mfma_f32_16x16x32_bf16(Bt[n][k], At[m][k], acc[ai][bj][m][n], 0, 0, 0); __builtin_amdgcn_s_setprio(0); } while (0)
#define PG8_WAIT_V(n) asm volatile("s_waitcnt vmcnt(" #n ")" ::: "memory")
#define PG8_WAIT_L(n) asm volatile("s_waitcnt lgkmcnt(" #n ")" ::: "memory")
#define PG8_BAR __builtin_amdgcn_s_barrier()
#define PG8_SCHED __builtin_amdgcn_sched_barrier(0)
    Unit cur, nxt; int ui = 0;
    if (!S.next(0, cur)) return;
    f32x4 acc[2][2][4][2];
#pragma unroll
    for (int a = 0; a < 2; ++a)
#pragma unroll
        for (int b = 0; b < 2; ++b)
#pragma unroll
            for (int m = 0; m < 4; ++m)
#pragma unroll
                for (int n = 0; n < 2; ++n) acc[a][b][m][n] = (f32x4){0.f, 0.f, 0.f, 0.f};
    bf16x8 At[4][2], B0[2][2], B1[2][2];
    const char* cA = cur.a; const char* cB = cur.b;
    if constexpr (GATHER) PG8_GOFF(oc, cur.rows);
    S.a_ready(cur);
    if constexpr (SP2) {
        PG8_STAGE(PG8_SB(0, 0), cB, voffB); PG8_STAGE(PG8_SB(0, 1), cB + hstepB, voffB); PG8_STAGE(PG8_SA(0, 0), cA, (GATHER ? oc[0] : voffA)); PG8_STAGE(PG8_SA(0, 1), cA + hstepA, (GATHER ? oc[1] : voffA));
        if (wr == 1) PG8_BAR;
        PG8_WAIT_V(2); PG8_BAR;
        PG8_STAGE(PG8_SB(1, 0), cB + kstep, voffB); PG8_STAGE(PG8_SA(1, 0), cA + kstep, (GATHER ? oc[0] : voffA)); PG8_STAGE(PG8_SB(1, 1), cB + hstepB + kstep, voffB);
        PG8_WAIT_V(6); PG8_BAR;
    } else {
        PG8_STAGE(PG8_SB(0, 0), cB, voffB); PG8_STAGE(PG8_SA(0, 0), cA, voffA); PG8_STAGE(PG8_SB(0, 1), cB + hstepB, voffB); PG8_STAGE(PG8_SA(0, 1), cA + hstepA, voffA);
        if (wr == 1) PG8_BAR;
        PG8_WAIT_V(4); PG8_BAR;
        PG8_STAGE(PG8_SB(1, 0), cB + kstep, voffB); PG8_STAGE(PG8_SA(1, 0), cA + kstep, voffA); PG8_STAGE(PG8_SB(1, 1), cB + hstepB + kstep, voffB);
        PG8_WAIT_V(6); PG8_BAR;
    }
    for (;;) {
        const bool has_next = S.next(ui + 1, nxt);
        if constexpr (GATHER) { if (has_next) { unsigned on[2][2]; PG8_GOFF(on, nxt.rows); *(PG8_LAS u32x4*)(lds + STAGE_BYTES + tid * 16) = (u32x4){on[0][0], on[0][1], on[1][0], on[1][1]}; } }
        const char* nA = has_next ? nxt.a : cA; const char* nB = has_next ? nxt.b : cB;
        for (int t = 0; t < nt; t += 2) {
            const bool last = (t == nt - 2);
            const char* a1 = cA + (size_t)(t + 1) * kstep;
            const char* a2 = last ? nA : cA + (size_t)(t + 2) * kstep; const char* b2 = last ? nB : cB + (size_t)(t + 2) * kstep;
            const char* a3 = a2 + kstep; const char* b3 = b2 + kstep;
            if (last && has_next) S.a_ready(nxt);
            unsigned sx0[2], sx1[2];
            if constexpr (GATHER) { sx0[0] = oc[0][0]; sx0[1] = oc[0][1]; sx1[0] = oc[1][0]; sx1[1] = oc[1][1];
                if (last && has_next) { const u32x4 nv = *(const PG8_LAS u32x4*)(lds + STAGE_BYTES + tid * 16); sx0[0] = nv[0]; sx0[1] = nv[1]; sx1[0] = nv[2]; sx1[1] = nv[3]; } }
            else { sx0[0] = voffA[0]; sx0[1] = voffA[1]; sx1[0] = voffA[0]; sx1[1] = voffA[1]; }
            if constexpr (SP2) {
            PG8_LDB(B0, 0, 0); PG8_LDB(B1, 0, 1); PG8_SCHED; PG8_LDA(At, 0, 0); PG8_STAGE(PG8_SA(1, 1), a1 + hstepA, (GATHER ? oc[1] : voffA));
            PG8_WAIT_V(8); PG8_WAIT_L(0); PG8_BAR; PG8_MMA(0, 0, At, B0); PG8_MMA(0, 1, At, B1); PG8_BAR; PG8_SCHED;
            PG8_LDA(At, 0, 1); PG8_STAGE(PG8_SB(0, 0), b2, voffB); PG8_STAGE(PG8_SB(0, 1), b2 + hstepB, voffB); PG8_STAGE(PG8_SA(0, 0), a2, sx0);
            PG8_WAIT_V(8); PG8_WAIT_L(0); PG8_BAR; PG8_MMA(1, 0, At, B0); PG8_MMA(1, 1, At, B1); PG8_BAR; PG8_SCHED;
            PG8_LDB(B0, 1, 0); PG8_LDB(B1, 1, 1); PG8_SCHED; PG8_LDA(At, 1, 0); PG8_STAGE(PG8_SA(0, 1), a2 + hstepA, sx1);
            PG8_WAIT_V(8); PG8_WAIT_L(0); PG8_BAR; PG8_MMA(0, 0, At, B0); PG8_MMA(0, 1, At, B1); PG8_BAR; PG8_SCHED;
            PG8_LDA(At, 1, 1); PG8_STAGE(PG8_SB(1, 0), b3, voffB); PG8_STAGE(PG8_SB(1, 1), b3 + hstepB, voffB); PG8_STAGE(PG8_SA(1, 0), a3, sx0);
            PG8_WAIT_V(8); PG8_WAIT_L(0); PG8_BAR; PG8_MMA(1, 0, At, B0); PG8_MMA(1, 1, At, B1); PG8_BAR; PG8_SCHED;
            } else {
            PG8_LDB(B0, 0, 0); PG8_SCHED; PG8_LDA(At, 0, 0); PG8_STAGE(PG8_SA(1, 1), a1 + hstepA, voffA);
            PG8_WAIT_L(8); PG8_BAR; PG8_WAIT_L(0); PG8_MMA(0, 0, At, B0); PG8_BAR; PG8_SCHED;
            PG8_LDB(B1, 0, 1); PG8_STAGE(PG8_SB(0, 0), b2, voffB);
            PG8_BAR; PG8_WAIT_L(0); PG8_MMA(0, 1, At, B1); PG8_BAR;
            PG8_LDA(At, 0, 1); PG8_STAGE(PG8_SA(0, 0), a2, voffA);
            PG8_BAR; PG8_WAIT_L(0); PG8_MMA(1, 0, At, B0); PG8_BAR; PG8_SCHED;
            PG8_STAGE(PG8_SB(0, 1), b2 + hstepB, voffB);
            PG8_WAIT_V(6); PG8_BAR; PG8_MMA(1, 1, At, B1); PG8_BAR;
            PG8_LDB(B0, 1, 0); PG8_SCHED; PG8_LDA(At, 1, 0); PG8_STAGE(PG8_SA(0, 1), a2 + hstepA, voffA);
            PG8_WAIT_L(8); PG8_BAR; PG8_WAIT_L(0); PG8_MMA(0, 0, At, B0); PG8_BAR; PG8_SCHED;
            PG8_LDB(B1, 1, 1); PG8_STAGE(PG8_SB(1, 0), b3, voffB);
            PG8_BAR; PG8_WAIT_L(0); PG8_MMA(0, 1, At, B1); PG8_BAR;
            PG8_LDA(At, 1, 1); PG8_STAGE(PG8_SA(1, 0), a3, voffA);
            PG8_BAR; PG8_WAIT_L(0); PG8_MMA(1, 0, At, B0); PG8_BAR; PG8_SCHED;
            PG8_STAGE(PG8_SB(1, 1), b3 + hstepB, voffB);
            PG8_WAIT_V(6); PG8_BAR; PG8_MMA(1, 1, At, B1); PG8_BAR;
            }
        }
        if constexpr (ALIGN_EPI) { if (wr == 0) PG8_BAR; }
        if constexpr (!Epi::AFTER_DRAIN) { E(acc, cur, wr, wc, fr, fq); S.done(cur); }
        if (!has_next) break;
#pragma unroll
        for (int a = 0; a < 2; ++a)
#pragma unroll
            for (int b = 0; b < 2; ++b)
#pragma unroll
                for (int m = 0; m < 4; ++m)
#pragma unroll
                    for (int n = 0; n < 2; ++n) acc[a][b][m][n] = (f32x4){0.f, 0.f, 0.f, 0.f};
        cur = nxt; cA = nA; cB = nB; ++ui;
        if constexpr (GATHER) { const u32x4 nv = *(const PG8_LAS u32x4*)(lds + STAGE_BYTES + tid * 16); oc[0][0] = nv[0]; oc[0][1] = nv[1]; oc[1][0] = nv[2]; oc[1][1] = nv[3]; }
        if constexpr (ALIGN_EPI) { if (wr == 1) PG8_BAR; }
    }
    PG8_WAIT_V(0);
    if constexpr (!ALIGN_EPI) { if (wr == 0) PG8_BAR; }
    PG8_BAR;
    if constexpr (Epi::AFTER_DRAIN) { E.fused(acc, cur, wr, wc, fr, fq, lds, wid, lane); S.done(cur); }
#undef PG8_GOFF
#undef PG8_SA
#undef PG8_SB
#undef PG8_STAGE
#undef PG8_LDA
#undef PG8_LDB
#undef PG8_MMA
#undef PG8_WAIT_V
#undef PG8_WAIT_L
#undef PG8_BAR
#undef PG8_SCHED
}
}

typedef float cv_f32x2 __attribute__((ext_vector_type(2))); typedef __bf16 cv_bf16x2 __attribute__((ext_vector_type(2)));
__device__ __forceinline__ unsigned cvtpk(float lo, float hi) { const cv_f32x2 v = {lo, hi}; const cv_bf16x2 b2 = __builtin_convertvector(v, cv_bf16x2); return __builtin_bit_cast(unsigned, b2); }
__device__ __forceinline__ float rdlane(float v, int k) { return __int_as_float(__builtin_amdgcn_readlane(__float_as_int(v), k)); }
template <int CTRL> __device__ __forceinline__ float dppf(float v) { return __int_as_float(__builtin_amdgcn_update_dpp(0, __float_as_int(v), CTRL, 0xf, 0xf, false)); }
__device__ __forceinline__ float rowsum16(float v) { v += dppf<0xB1>(v); v += dppf<0x4E>(v); v += dppf<0x141>(v); v += dppf<0x140>(v); return v; }
#define LAS __attribute__((address_space(3)))
#define LDS_BARRIER() do { asm volatile("s_waitcnt lgkmcnt(0)" ::: "memory"); __builtin_amdgcn_s_barrier(); asm volatile("" ::: "memory"); } while (0)
typedef unsigned v4u __attribute__((ext_vector_type(4)));
typedef float f32x4 __attribute__((ext_vector_type(4)));

#define XB_TMO      128
#define XB_XCNT(j)  (256  + 64 * (j))
#define XB_XSUB(j)  (1280 + 64 * (j))
#define XB_XGEN(j)  (2304 + 64 * (j))
#define XB_TOP      3328
#define XB_TOPGEN   3392
#define XCD_BAR_WORDS 3456
#define XB_SPIN_CAP (1u << 18)
__device__ __forceinline__ unsigned xb_ld(unsigned* p)              { return __hip_atomic_load(p, __ATOMIC_RELAXED, __HIP_MEMORY_SCOPE_AGENT); }
__device__ __forceinline__ unsigned xb_add(unsigned* p, unsigned v) { return __hip_atomic_fetch_add(p, v, __ATOMIC_RELAXED, __HIP_MEMORY_SCOPE_AGENT); }
__device__ __forceinline__ unsigned xb_xcc_id() { return (unsigned)__builtin_amdgcn_s_getreg((3 << 11) | 20) & 0xFu; }
#define XB_SPIN(cond, bar) do { unsigned _sp = 0; while (cond) { __builtin_amdgcn_s_sleep(1); \
    if ((++_sp & 255u) == 0u) { if (xb_ld(&(bar)[XB_TMO])) break; if (_sp > XB_SPIN_CAP) { atomicAdd(&(bar)[XB_TMO], 1u); break; } } } } while (0)
struct XcdBarrier { unsigned* bar; unsigned x; volatile LAS unsigned* st; };
__device__ __forceinline__ XcdBarrier xcd_barrier_post(unsigned* bar, volatile LAS unsigned* st, bool t0) {
    XcdBarrier b; b.bar = bar; b.x = xb_xcc_id(); b.st = st;
    if (t0) (void)xb_add(&bar[XB_XCNT(b.x)], 1u);
    return b;
}
__device__ __forceinline__ void xcd_barrier_complete(unsigned* bar, unsigned x, unsigned& nloc, unsigned& nx) {
    const unsigned G = gridDim.x * gridDim.y * gridDim.z;
    unsigned sum, cnt, mine, sp = 0u;
    for (;;) {
        sum = 0u; cnt = 0u; mine = 0u;
#pragma unroll
        for (unsigned j = 0; j < 16; ++j) { const unsigned c = xb_ld(&bar[XB_XCNT(j)]); sum += c; cnt += (c > 0u) ? 1u : 0u; mine = (j == x) ? c : mine; }
        if (sum == G) break;
        __builtin_amdgcn_s_sleep(1);
        if ((++sp & 255u) == 0u) { if (xb_ld(&bar[XB_TMO])) break; if (sp > XB_SPIN_CAP) { atomicAdd(&bar[XB_TMO], 1u); break; } }
    }
    nloc = mine > 0u ? mine : 1u; nx = cnt > 0u ? cnt : 1u;
}
__device__ __forceinline__ void xcd_barrier(const XcdBarrier& b, int wv_) {
    asm volatile("s_waitcnt vmcnt(0)" ::: "memory");
    __syncthreads();
    if (make_tid(wv_) == 0) {
        unsigned* bar = b.bar; asm volatile("" : "+s"(bar)); const unsigned bx = xb_xcc_id();
        __builtin_amdgcn_s_waitcnt(0);
        unsigned nloc = b.st[0], nx = b.st[1];
        if (nloc == 0u) { xcd_barrier_complete(bar, bx, nloc, nx); b.st[0] = nloc; b.st[1] = nx; }
        const unsigned old = xb_add(&bar[XB_XSUB(bx)], 1u);
        const unsigned gen = old / nloc;
        if (old + 1u == (gen + 1u) * nloc) {
            __builtin_amdgcn_fence(__ATOMIC_RELEASE, "agent");
            asm volatile("s_waitcnt vmcnt(0)" ::: "memory");
            const unsigned og = xb_add(&bar[XB_TOP], 1u);
            const unsigned tg = og / nx;
            if (og + 1u == (tg + 1u) * nx) xb_add(&bar[XB_TOPGEN], 1u);
            else XB_SPIN(xb_ld(&bar[XB_TOPGEN]) == tg, bar);
            __builtin_amdgcn_fence(__ATOMIC_ACQUIRE, "agent");
            xb_add(&bar[XB_XGEN(bx)], 1u);
            asm volatile("s_waitcnt vmcnt(0)" ::: "memory");
        } else {
            XB_SPIN(xb_ld(&bar[XB_XGEN(bx)]) == gen, bar);
            __builtin_amdgcn_fence(__ATOMIC_ACQUIRE, "agent");
            asm volatile("s_waitcnt vmcnt(0)" ::: "memory");
        }
    }
    __syncthreads();
}
struct SchedStatic {
    const char* A; const char* B; int nM, nN, nwg, G, c; size_t tstepA, tstepB;
    __device__ void init(const void* A_, const void* B_, int M, int N, int K, int G_, int c_, int lda = 0) { A = (const char*)A_; B = (const char*)B_; nM = M / 256; nN = N / 256; nwg = nM * nN; G = G_; c = c_; tstepB = (size_t)256 * K * 2; tstepA = (size_t)256 * (lda ? lda : K) * 2; }
    __device__ bool next(int i, pg8::Unit& u) const {
        const long Lx = (long)i * G + c; if (Lx >= nwg) return false;
        int wgid = (int)Lx; { const int q = nwg / 8, r = nwg % 8, xcd = wgid % 8, off = wgid / 8; wgid = (xcd < r ? xcd * (q + 1) : r * (q + 1) + (xcd - r) * q) + off; }
        const int nig = 8 * nN, gid = wgid / nig, fm = gid * 8, gsz = (nM - fm) < 8 ? (nM - fm) : 8;
        u.pm = fm + ((wgid % nig) % gsz); u.pn = (wgid % nig) / gsz; u.a = A + (size_t)u.pm * tstepA; u.b = B + (size_t)u.pn * tstepB; u.rows = nullptr; return true;
    }
    __device__ __forceinline__ void a_ready(const pg8::Unit&) const {}
    __device__ __forceinline__ void done(const pg8::Unit&) const {}
};
struct EpiBf16Store {
    static constexpr bool PERM = true, AFTER_DRAIN = false;
    pt* O; int ldc;
    __device__ __forceinline__ void operator()(const f32x4 (&acc)[2][2][4][2], const pg8::Unit& u, int wr, int wc, int fr, int fq) const {
        const int row0 = u.pm * 256 + wr * 64 + fr, col0 = u.pn * 256 + wc * 32 + 8 * fq;
#pragma unroll
        for (int ai = 0; ai < 2; ++ai)
#pragma unroll
            for (int m = 0; m < 4; ++m) { pt* rowp = O + (size_t)(row0 + ai * 128 + m * 16) * ldc + col0;
#pragma unroll
                for (int bj = 0; bj < 2; ++bj) { const f32x4 v0 = acc[ai][bj][m][0], v1 = acc[ai][bj][m][1]; v4u w;
                    w.x = cvtpk(v0[0], v0[1]); w.y = cvtpk(v0[2], v0[3]); w.z = cvtpk(v1[0], v1[1]); w.w = cvtpk(v1[2], v1[3]);
                    *(v4u*)(rowp + bj * 128) = w; } }
    }
};

struct EpiProjAct {
    static constexpr bool PERM = true, AFTER_DRAIN = false;
    pt* O; int ldc; const float* lb;
    __device__ __forceinline__ void operator()(const f32x4 (&acc)[2][2][4][2], const pg8::Unit& u, int wr, int wc, int fr, int fq) const {
        const int row0 = u.pm * 256 + wr * 64 + fr, col0 = u.pn * 256 + wc * 32 + 8 * fq;
#define EPA_ROWS(BODY_) _Pragma("unroll") for (int ai = 0; ai < 2; ++ai) _Pragma("unroll") for (int m = 0; m < 4; ++m) { pt* rowp = O + (size_t)(row0 + ai * 128 + m * 16) * ldc + col0 + bj * 128; float v[8]; \
            _Pragma("unroll") for (int i = 0; i < 8; ++i) { const float x = acc[ai][bj][m][i >> 2][i & 3]; float y; BODY_; v[i] = y; } \
            v4u w; w.x = cvtpk(v[0], v[1]); w.y = cvtpk(v[2], v[3]); w.z = cvtpk(v[4], v[5]); w.w = cvtpk(v[6], v[7]); if (col0 + bj * 128 < DIN) *(v4u*)rowp = w; }
#pragma unroll
        for (int bj = 0; bj < 2; ++bj) { const int cs = u.pn * 256 + bj * 128;
            const int kind = (cs >= C_GG && cs < C_HF) ? 1 : (cs >= C_HF && cs < C_HGT) ? 3 : (cs >= C_HGT && cs < C_GA) ? 2 : 0;
            if (kind == 0) { EPA_ROWS(y = x) }
            else if (kind == 1) { EPA_ROWS(y = x * __builtin_amdgcn_rcpf(1.0f + __builtin_amdgcn_exp2f(-1.4426950408889634f * x))) }
            else if (kind == 2) { EPA_ROWS(y = __builtin_amdgcn_rcpf(1.0f + __builtin_amdgcn_exp2f(-1.4426950408889634f * x))) }
            else { f32x4 l0, l1;
                { const f32x4 t0_ = *(const f32x4*)(lb + (col0 + bj * 128 - C_HF)), t1_ = *(const f32x4*)(lb + (col0 + bj * 128 - C_HF) + 4);
#pragma unroll
                  for (int i = 0; i < 4; ++i) { asm volatile("v_mov_b32 %0, %1" : "=v"(l0[i]) : "v"(t0_[i])); asm volatile("v_mov_b32 %0, %1" : "=v"(l1[i]) : "v"(t1_[i])); } }
                EPA_ROWS(const float t = __builtin_amdgcn_exp2f(-1.4426950408889634f * fabsf(x)); const float lbv = i < 4 ? l0[i & 3] : l1[i & 3]; const float sx = x >= 0.f ? 1.0f : t; const float num = lbv * (1.0f + t) + (1.0f - lbv) * sx; \
                         const float lg = 0.6931471805599453f * __builtin_amdgcn_logf(num * __builtin_amdgcn_rcpf(1.0f + t)); y = (lbv == 0.f && x < -80.f) ? x : lg) }
        }
#undef EPA_ROWS
    }
};
struct EpiF32Store {
    static constexpr bool PERM = false, AFTER_DRAIN = false;
    float* C; int ldc;
    __device__ __forceinline__ void operator()(const f32x4 (&acc)[2][2][4][2], const pg8::Unit& u, int wr, int wc, int fr, int fq) const {
        const int row0 = u.pm * 256 + wr * 64 + fr, col0 = u.pn * 256 + wc * 32 + 4 * fq;
#pragma unroll
        for (int ai = 0; ai < 2; ++ai)
#pragma unroll
            for (int m = 0; m < 4; ++m) { float* rowp = C + (size_t)(row0 + ai * 128 + m * 16) * ldc + col0;
#pragma unroll
                for (int bj = 0; bj < 2; ++bj)
#pragma unroll
                    for (int n = 0; n < 2; ++n) *(f32x4*)(rowp + bj * 128 + n * 16) = acc[ai][bj][m][n]; }
    }
};

struct SchedMoE {
    const char* A; const char* Bw; const int* rowtab; int te[16]; int ntiles, G, c; size_t tstepA, estepB, tstepB;
    __device__ __forceinline__ void init(const void* A_, const void* B_, int K, const int* CNT, size_t estepB_, int G_, int c_, const int* rowtab_ = nullptr) {
        A = (const char*)A_; Bw = (const char*)B_; G = G_; c = c_; tstepA = rowtab_ ? (size_t)0 : (size_t)256 * K * 2; tstepB = (size_t)256 * K * 2; estepB = estepB_; rowtab = rowtab_;
        int acc = 0;
#pragma unroll
        for (int e = 0; e < 16; ++e) { acc += (__builtin_amdgcn_readfirstlane(CNT[e]) + 255) >> 8; te[e] = acc; }
        ntiles = acc;
    }
    __device__ __forceinline__ bool next(int i, pg8::Unit& u) const {
        const int Lx = i * G + c; if (Lx >= ntiles * 4) return false;
        const int tile = Lx >> 2; int e = 0;
#pragma unroll
        for (int k = 0; k < 15; ++k) e += (tile >= te[k]) ? 1 : 0;
        u.pm = tile; u.pn = Lx & 3; u.a = A + (size_t)tile * tstepA; u.b = Bw + (size_t)e * estepB + (size_t)u.pn * tstepB; u.rows = rowtab + (size_t)tile * 256; return true;
    }
    __device__ __forceinline__ void a_ready(const pg8::Unit&) const {}
    __device__ __forceinline__ void done(const pg8::Unit&) const {}
};
struct EpiSiluMul {
    static constexpr bool PERM = true, AFTER_DRAIN = false;
    pt* O;
    __device__ __forceinline__ void operator()(const f32x4 (&acc)[2][2][4][2], const pg8::Unit& u, int wr, int wc, int fr, int fq) const {
        const int row0 = u.pm * 256 + wr * 64 + fr, col0 = u.pn * 128 + wc * 32 + 8 * fq;
#pragma unroll
        for (int ai = 0; ai < 2; ++ai)
#pragma unroll
            for (int m = 0; m < 4; ++m) { pt* rowp = O + (size_t)(row0 + ai * 128 + m * 16) * 512 + col0; float h[8];
#pragma unroll
                for (int n = 0; n < 2; ++n)
#pragma unroll
                    for (int i = 0; i < 4; ++i) { const float g = acc[ai][0][m][n][i], up = acc[ai][1][m][n][i]; h[n * 4 + i] = g * __builtin_amdgcn_rcpf(1.0f + __builtin_amdgcn_exp2f(-1.4426950408889634f * g)) * up; }
                v4u w; w.x = cvtpk(h[0], h[1]); w.y = cvtpk(h[2], h[3]); w.z = cvtpk(h[4], h[5]); w.w = cvtpk(h[6], h[7]);
                *(v4u*)rowp = w; }
    }
};

typedef float f32x16 __attribute__((ext_vector_type(16)));
typedef short hbf16x8 __attribute__((ext_vector_type(8)));
typedef unsigned v2u __attribute__((ext_vector_type(2)));
constexpr int HY_ZPAD = 1024, HY_ZROW = SEQ_ + 2 * HY_ZPAD, HY_ZROWB = (HY_ZROW + 8 * (HY_ZROW / 128) + 64) * 2;
constexpr int HY_ZBYTES = 4 * HY_ZROWB, HY_RINGB = 512 * 2 + 64, HY_FWAVE = 8 * HY_RINGB, HY_LDS = HY_ZBYTES + 8 * HY_FWAVE;
static_assert(SEQ_ != 8192 || (HY_ZROWB % 256 == 128 && HY_LDS <= 163840), "hyena LDS map");
__device__ __forceinline__ int hy_zoff(int s) { const int p = s + HY_ZPAD; return (p + 8 * (p >> 7)) * 2; }
struct MoeCvt { const float* wg; long dgu; const float* wd; pt* WguT; pt* WdT; int it, step; };
constexpr int MC_IGU = 16 * 2 * 16 * 16, MC_NIT = MC_IGU + 16 * 8 * 32;
__device__ __forceinline__ void moe_item(const MoeCvt& m, int q, int lane, const float*& src, int& lsrc, pt*& dst) {
    const int n = lane & 31, ko = (lane >> 5) * 32 + (q & 1) * 16; int r = __builtin_amdgcn_readfirstlane(m.it + (q >> 1) * m.step);
    if (r < MC_IGU) { const int e = r / 512, hf = (r / 256) & 1, kb = (r / 16) & 15, nb = r & 15; lsrc = 512;
        src = (const float*)((const char*)m.wg + (long)hf * m.dgu) + (size_t)e * DM * 512 + (size_t)(kb * 64 + ko) * 512 + nb * 32 + n;
        dst = m.WguT + (size_t)e * 1024 * 1024 + (size_t)((nb >> 2) * 256 + hf * 128 + (nb & 3) * 32 + n) * 1024 + kb * 64 + ko; }
    else { r -= MC_IGU; const int e = r / 256, kb = (r / 32) & 7, nb = r & 31; lsrc = DM;
        src = m.wd + (size_t)e * 512 * DM + (size_t)(kb * 64 + ko) * DM + nb * 32 + n;
        dst = m.WdT + (size_t)e * 1024 * 512 + (size_t)(nb * 32 + n) * 512 + kb * 64 + ko; }
}
#define MC_VALID(m_, q_) ((m_).it + ((q_) >> 1) * (m_).step < MC_NIT)
#define MC_LOAD(m_, q_, cv_) do { const float* s_; int ls_; pt* d_; moe_item(m_, q_, lane, s_, ls_, d_); _Pragma("unroll") for (int i_ = 0; i_ < 16; ++i_) cv_[i_] = s_[(size_t)i_ * ls_]; } while (0)
#define MC_STORE(m_, q_, cv_) do { const float* s_; int ls_; pt* d_; moe_item(m_, q_, lane, s_, ls_, d_); _Pragma("unroll") for (int h_ = 0; h_ < 2; ++h_) { v4u o_; \
        o_.x = cvtpk(cv_[8 * h_], cv_[8 * h_ + 1]); o_.y = cvtpk(cv_[8 * h_ + 2], cv_[8 * h_ + 3]); o_.z = cvtpk(cv_[8 * h_ + 4], cv_[8 * h_ + 5]); o_.w = cvtpk(cv_[8 * h_ + 6], cv_[8 * h_ + 7]); \
        *(v4u*)(d_ + 8 * h_) = o_; } } while (0)
struct P2Side { pt* ds; const float* dd; int K, d; bool act; };
constexpr int P2_NT = NB * 12 * 1536, P2_NCH = SEQ_ / 64;
__device__ __forceinline__ P2Side p2_side_init(pt* DS_gla, float* DD_gla, pt* DS_hg, float* DD_hg, int wave_global, int nwaves, int lane) {
    const int per = (P2_NT + nwaves - 1) / nwaves; const size_t id = (size_t)wave_global * per + lane; P2Side r; r.act = lane < per && id < (size_t)P2_NT; const size_t idc = r.act ? id : 0;
    const bool hg = idc < (size_t)NB * 6 * 2 * 1024; const int K = hg ? 64 : 32; const size_t i2 = hg ? idc : idc - (size_t)NB * 6 * 2 * 1024;
    const int pe = 64 * K / 4; const int sd = (int)(i2 / pe), rem = (int)(i2 % pe), v = rem / (K / 4), kq = rem % (K / 4);
    r.K = K; r.d = sd & 1; r.ds = (hg ? DS_hg : DS_gla) + (size_t)sd * P2_NCH * 64 * K + (size_t)v * K + 4 * kq; r.dd = (hg ? DD_hg : DD_gla) + (size_t)sd * P2_NCH * K + 4 * kq; return r;
}
#define P2_LOAD(dv_, de_, tt_) do { const int nn_ = 2 * (tt_); if (nn_ < P2_NCH && ps.act) { _Pragma("unroll") for (int j_ = 0; j_ < 2; ++j_) { const int n_ = ps.d ? P2_NCH - 1 - (nn_ + j_) : nn_ + j_; \
        dv_[j_] = *(const v2u*)(ps.ds + (size_t)n_ * 64 * ps.K); de_[j_] = *(const f32x4*)(ps.dd + (size_t)n_ * ps.K); } } } while (0)
#define P2_PROC(dv_, de_, tt_) do { const int nn_ = 2 * (tt_); if (nn_ < P2_NCH && ps.act) { v2u o_[2];   \
        _Pragma("unroll") for (int j_ = 0; j_ < 2; ++j_) { o_[j_].x = cvtpk(PS0, PS1); o_[j_].y = cvtpk(PS2, PS3); \
            PS0 = de_[j_][0] * PS0 + __uint_as_float(dv_[j_].x << 16); PS1 = de_[j_][1] * PS1 + __uint_as_float(dv_[j_].x & 0xffff0000u); \
            PS2 = de_[j_][2] * PS2 + __uint_as_float(dv_[j_].y << 16); PS3 = de_[j_][3] * PS3 + __uint_as_float(dv_[j_].y & 0xffff0000u); } \
        _Pragma("unroll") for (int j_ = 0; j_ < 2; ++j_) { const int n_ = ps.d ? P2_NCH - 1 - (nn_ + j_) : nn_ + j_; *(v2u*)(ps.ds + (size_t)n_ * 64 * ps.K) = o_[j_]; } } } while (0)
#define P2_HOOK(dv_, de_) do { if (pt2 >= 2) P2_PROC(dv_, de_, pt2 - 2); P2_LOAD(dv_, de_, pt2); ++pt2; } while (0)
template <int SIDE = 0> __device__ __forceinline__ void hy_conv_mfma(LAS unsigned char* lds, const pt* zsrc, int zc, const pt* gate, int gc, const pt* RFo, const float* invn, const float* bias, pt* out, int oc_, int wv_, MoeCvt mc = MoeCvt(), P2Side ps = P2Side()) {
    const int tix = opaque_tid(), lane = tix & 63, w = __builtin_amdgcn_readfirstlane(tix >> 6), n = lane & 31, h = lane >> 5;
    const bool g1 = (n >= 4 && n < 12) || (n >= 16 && n < 20) || (n >= 28);
    const int rank = g1 ? (n < 12 ? n - 4 : (n < 20 ? n - 8 : n - 16)) : (n < 4 ? n : (n < 16 ? n - 8 : n - 12));
    const int b = (g1 ? 2 : 0) + (rank & 1), iota = rank >> 1;
    const int zlane = b * HY_ZROWB + 272 * iota + 16 * h;
    const int a = (7 - n) & 7, alane = 16 * h - 16 * (n >> 3) + 64, fwave = HY_ZBYTES + w * HY_FWAVE, fa = fwave + a * HY_RINGB;
    const int Yb = SEQ_ - 1025 - 1024 * w; int mq = 0;
    const int mqmax = SIDE == 1 ? 2 * ((MC_NIT - 1 - mc.it) / mc.step) + 1 : -1;
#define MCQ(q_) ((q_) < mqmax ? (q_) : mqmax)
    int pt2 = 0; float PS0 = 0.f, PS1 = 0.f, PS2 = 0.f, PS3 = 0.f; v2u pdv0[2], pdv1[2]; f32x4 pde0[2], pde1[2];
#pragma unroll
    for (int j = 0; j < 2; ++j) { pdv0[j] = pdv1[j] = (v2u){0u, 0u}; pde0[j] = pde1[j] = (f32x4){0.f, 0.f, 0.f, 0.f}; }
    for (int c = blockIdx.x; c < 256; c += gridDim.x) {
        { const v4u zz = {0u, 0u, 0u, 0u}; for (int u = tix; u < HY_ZBYTES / 16; u += 512) *(LAS v4u*)(lds + u * 16) = zz; }
        __syncthreads();
        for (int u = tix; u < 4 * (SEQ_ / 8); u += 512) { const int bb = u / (SEQ_ / 8), s8 = (u % (SEQ_ / 8)) * 8;
            const v4u v = *(const v4u*)(zsrc + ((size_t)bb * zc + c) * SEQ_ + s8); *(LAS v4u*)(lds + bb * HY_ZROWB + hy_zoff(s8)) = v; }
        const pt* rf = RFo + (size_t)c * RFL;
#define HY_LOADCH(kc) (*(const unsigned*)(rf + (Yb + 128 * (kc) + 97 + 2 * lane)))
#define HY_WRITECH(kc, v) do { _Pragma("unroll") for (int a2 = 0; a2 < 8; ++a2) { const int rho = (128 * (kc) + 2 * lane + 7 - a2) & 511; LAS unsigned char* cp = lds + fwave + a2 * HY_RINGB; \
            if (a2 & 1) *(LAS unsigned*)(cp + 2 * rho) = (v); else { *(LAS unsigned short*)(cp + 2 * rho) = (unsigned short)((v) & 0xffffu); *(LAS unsigned short*)(cp + 2 * ((rho + 1) & 511)) = (unsigned short)((v) >> 16); } } } while (0)
        { const unsigned v0 = HY_LOADCH(0), v1 = HY_LOADCH(1); HY_WRITECH(0, v0); HY_WRITECH(1, v1); }
        __syncthreads();
        f32x16 acc[4];
#pragma unroll
        for (int q = 0; q < 4; ++q)
#pragma unroll
            for (int r = 0; r < 16; ++r) acc[q][r] = 0.f;
        hbf16x8 Bt[4][2];
#pragma unroll
        for (int q = 0; q < 4; ++q) { Bt[q][0] = *(const LAS hbf16x8*)(lds + zlane + 64 * q); Bt[q][1] = *(const LAS hbf16x8*)(lds + zlane + 64 * q + 32); }
        unsigned pq[6];
#pragma unroll
        for (int i = 0; i < 6; ++i) pq[i] = HY_LOADCH(2 + i);
        float cv[16];
#pragma unroll
        for (int i = 0; i < 16; ++i) cv[i] = 0.f;
        if constexpr (SIDE == 1) MC_LOAD(mc, MCQ(mq), cv);
#pragma unroll 1
        for (int k6 = 0; k6 < 72; k6 += 6) {
            if constexpr (SIDE == 1) { MC_STORE(mc, MCQ(mq), cv); MC_LOAD(mc, MCQ(mq + 1), cv); ++mq; }
#pragma unroll
            for (int ki = 0; ki < 6; ++ki) { const int k = k6 + ki;
#pragma unroll
                for (int j = 0; j < 4; ++j) {
                    const hbf16x8 A0 = *(const LAS hbf16x8*)(lds + fa + ((256 * k + 64 * j + alane) & 1023));
                    const hbf16x8 A1 = *(const LAS hbf16x8*)(lds + fa + ((256 * k + 64 * j + 32 + alane) & 1023));
                    const hbf16x8 Bn0 = *(const LAS hbf16x8*)(lds + zlane + 272 * (k + 1) + 64 * j);
                    const hbf16x8 Bn1 = *(const LAS hbf16x8*)(lds + zlane + 272 * (k + 1) + 64 * j + 32);
#pragma unroll
                    for (int q = 0; q < 4; ++q) acc[q] = __builtin_amdgcn_mfma_f32_32x32x16_bf16(A0, Bt[q][0], acc[q], 0, 0, 0);
#pragma unroll
                    for (int q = 0; q < 4; ++q) acc[q] = __builtin_amdgcn_mfma_f32_32x32x16_bf16(A1, Bt[q][1], acc[q], 0, 0, 0);
                    Bt[0][0] = Bt[1][0]; Bt[0][1] = Bt[1][1]; Bt[1][0] = Bt[2][0]; Bt[1][1] = Bt[2][1]; Bt[2][0] = Bt[3][0]; Bt[2][1] = Bt[3][1]; Bt[3][0] = Bn0; Bt[3][1] = Bn1;
                }
                const unsigned pv = pq[ki];
                HY_WRITECH(k + 2, pv);
                pq[ki] = HY_LOADCH(k + 8 < 74 ? k + 8 : 73);
                if constexpr (SIDE == 2) { if (ki & 1) P2_HOOK(pdv1, pde1); else P2_HOOK(pdv0, pde0); }
            }
        }

        const float sc = invn[c], bi = bias[c];
        v2u gva[4][4];
#pragma unroll
        for (int q = 0; q < 4; ++q)
#pragma unroll
            for (int rg = 0; rg < 4; ++rg) gva[q][rg] = *(const v2u*)(gate + ((size_t)b * gc + c) * SEQ_ + 32 * (32 * w + 4 * iota + q) + 8 * rg + 4 * h);
#pragma unroll
        for (int q = 0; q < 4; ++q)
#pragma unroll
            for (int rg = 0; rg < 4; ++rg) {
                const int t0 = 32 * (32 * w + 4 * iota + q) + 8 * rg + 4 * h;
                const v2u zv = *(const LAS v2u*)(lds + b * HY_ZROWB + hy_zoff(t0));
                const v2u gv = gva[q][rg];
                float o[4];
#pragma unroll
                for (int e = 0; e < 4; ++e) { const unsigned zw = e < 2 ? zv.x : zv.y, gw = e < 2 ? gv.x : gv.y; const float zf = __uint_as_float((e & 1) ? (zw & 0xffff0000u) : (zw << 16)), gf = __uint_as_float((e & 1) ? (gw & 0xffff0000u) : (gw << 16));
                    o[e] = gf * (acc[q][rg * 4 + e] * sc + zf * bi); }
                v2u ov; ov.x = f2bf(o[0]) | (f2bf(o[1]) << 16); ov.y = f2bf(o[2]) | (f2bf(o[3]) << 16);
                *(v2u*)(out + ((size_t)b * oc_ + c) * SEQ_ + t0) = ov;
            }
        __syncthreads();
    }
    if constexpr (SIDE == 2) { while (pt2 < P2_NCH / 2 + 2) { P2_HOOK(pdv0, pde0); P2_HOOK(pdv1, pde1); } }
    if constexpr (SIDE == 1) { for (; mq <= mqmax; ++mq) { float cv[16]; MC_LOAD(mc, mq, cv); MC_STORE(mc, mq, cv); } }
#undef HY_LOADCH
#undef HY_WRITECH
}
constexpr int SC_NCH = SEQ_ / 64, SC_HALF = 81920;
typedef short sbf16x8 __attribute__((ext_vector_type(8)));
typedef float f32x2 __attribute__((ext_vector_type(2)));
struct ScanP { const pt* proj; const float* wa2; const float* ba; const float* lb; pt* DS; float* DD; pt* mixin; const float* gain; pt* AL; int ms; };
struct GateCtx { float wa[2][16]; float c0[2]; };
__device__ __forceinline__ void sc_sig(float z, float& sg, float& omsg, float& e) { e = __expf(-fabsf(z)); const float inv = __builtin_amdgcn_rcpf(1.0f + e); const float a = inv, b2 = e * inv; sg = z >= 0.f ? a : b2; omsg = z >= 0.f ? b2 : a; }
template <int GRP> __device__ __forceinline__ void sc_ctx(const ScanP& A, int h, int k2, int d, GateCtx& c) {
    int off = (GRP ? h * 64 : h * 32) + k2; asm volatile("" : "+v"(off));
#pragma unroll
    for (int j = 0; j < 2; ++j) {
        if constexpr (GRP == 0) {
#pragma unroll
            for (int r = 0; r < 16; ++r) c.wa[j][r] = A.wa2[(d * 16 + r) * 192 + off + j];
            c.c0[j] = A.ba[d * 192 + off + j]; }
        else c.c0[j] = A.lb[d * 384 + off + j]; }
}
template <int GRP> struct GateRaw { v4u a0, a1; unsigned kw; };
template <> struct GateRaw<1> { unsigned kw; };
template <int GRP> __device__ __forceinline__ void sc_gate_load(const ScanP& A, size_t row, int h, int k2, int d, GateRaw<GRP>& R) {
    if constexpr (GRP == 0) { R.a0 = *(const v4u*)(A.proj + row * NPS + C_GA + 16 * d); R.a1 = *(const v4u*)(A.proj + row * NPS + C_GA + 16 * d + 8); R.kw = *(const unsigned*)(A.proj + row * NPS + C_GK + h * 32 + k2); }
    else R.kw = *(const unsigned*)(A.proj + row * NPS + C_HF + d * 384 + h * 64 + k2);
}
template <int GRP> __device__ __forceinline__ void sc_gate(const GateCtx& c, const GateRaw<GRP>& R, float (&g)[2], float (&kd)[2]) {
    if constexpr (GRP == 0) {
#pragma unroll
        for (int j = 0; j < 2; ++j) { float al = c.c0[j];
#pragma unroll
            for (int r = 0; r < 4; ++r) { al += __uint_as_float(R.a0[r] << 16) * c.wa[j][2 * r] + __uint_as_float(R.a0[r] & 0xffff0000u) * c.wa[j][2 * r + 1]; al += __uint_as_float(R.a1[r] << 16) * c.wa[j][8 + 2 * r] + __uint_as_float(R.a1[r] & 0xffff0000u) * c.wa[j][8 + 2 * r + 1]; }
            g[j] = (fminf(al, 0.f) - 0.6931471805599453f * __builtin_amdgcn_logf(1.0f + __builtin_amdgcn_exp2f(-1.4426950408889634f * fabsf(al)))) * (1.0f / 16.0f); }
        kd[0] = __uint_as_float(R.kw << 16); kd[1] = __uint_as_float(R.kw & 0xffff0000u); }
    else {
#pragma unroll
        for (int j = 0; j < 2; ++j) { g[j] = j ? __uint_as_float(R.kw & 0xffff0000u) : __uint_as_float(R.kw << 16); kd[j] = 1.0f - __expf(g[j]); } }
}
template <int GRP> __device__ __forceinline__ unsigned sc_q_load(const ScanP& A, size_t row, int h, int k2) { return *(const unsigned*)(A.proj + row * NPS + (GRP ? C_HQ + h * 64 : C_GQ + h * 32) + k2); }
struct GateLite { unsigned gw, kw; };
__device__ __forceinline__ void sc_lite_load(const ScanP& A, size_t row, int h, int k2, int d, GateLite& R) { R.gw = *(const unsigned*)(A.AL + ((size_t)d * T + row) * 192 + h * 32 + k2); R.kw = *(const unsigned*)(A.proj + row * NPS + C_GK + h * 32 + k2); }
__device__ __forceinline__ void sc_lite(const GateLite& R, float (&g)[2], float (&kd)[2]) { g[0] = __uint_as_float(R.gw << 16); g[1] = __uint_as_float(R.gw & 0xffff0000u); kd[0] = __uint_as_float(R.kw << 16); kd[1] = __uint_as_float(R.kw & 0xffff0000u); }
template <int GRP> __device__ __forceinline__ void sc_q(unsigned w, float (&q)[2]) {
    if constexpr (GRP == 0) { q[0] = __uint_as_float(w << 16) * 0.17677669529663687f; q[1] = __uint_as_float(w & 0xffff0000u) * 0.17677669529663687f; }
    else { q[0] = __uint_as_float(w << 16); q[1] = __uint_as_float(w & 0xffff0000u); }
}
__device__ __forceinline__ void sc_vt_load(unsigned (&vw)[8], const pt* proj, size_t row0, int col0, int tid2) {
#pragma unroll
    for (int j = 0; j < 8; ++j) { const int idx = tid2 + 256 * j, vp = idx & 31, t = idx >> 5; vw[j] = *(const unsigned*)(proj + (row0 + t) * NPS + col0 + 2 * vp); }
}
__device__ __forceinline__ void sc_vt_store(LAS unsigned short* VT, const unsigned (&vw)[8], int tid2) {
#pragma unroll
    for (int j = 0; j < 8; ++j) { const int idx = tid2 + 256 * j, vp = idx & 31, t = idx >> 5; VT[(2 * vp) * 72 + t] = (unsigned short)(vw[j] & 0xffffu); VT[(2 * vp + 1) * 72 + t] = (unsigned short)(vw[j] >> 16); }
}
#define P1_CTX(d_) do { if constexpr (GRP == 0) { _Pragma("unroll") for (int r_ = 0; r_ < 16; ++r_) { const f32x2 w_ = *(const LAS f32x2*)(CW + ((d_) * 16 + r_) * 192 + ch * 32 + k2); cx.wa[0][r_] = w_[0]; cx.wa[1][r_] = w_[1]; } \
        const f32x2 b_ = *(const LAS f32x2*)(CW + 6144 + (d_) * 192 + ch * 32 + k2); cx.c0[0] = b_[0]; cx.c0[1] = b_[1]; } } while (0)
template <int GRP> __device__ __forceinline__ void scan_p1(LAS unsigned char* lds, const ScanP A, int wv_) {
    constexpr int K = GRP ? 64 : 32, KP = K / 2, NSEG = 256 / KP, SL = 64 / NSEG, CV = GRP ? C_HI : C_GV;
    const int tix = opaque_tid(), half = tix >> 8, tid2 = tix & 255, lane = tix & 63, w4 = __builtin_amdgcn_readfirstlane((tix >> 6) & 3), r = lane & 15, g4 = lane >> 4;
    LAS unsigned char* hl = lds + half * SC_HALF;
    LAS f32x2* TOT0 = (LAS f32x2*)hl; LAS f32x2* TOT1 = (LAS f32x2*)(hl + 4096);
    LAS unsigned short* VT = (LAS unsigned short*)(hl + 8192); LAS unsigned short* KT0 = (LAS unsigned short*)(hl + 17408); LAS unsigned short* KT1 = (LAS unsigned short*)(hl + 26624);
    const int kp = tid2 % KP, seg = tid2 / KP, k2 = 2 * kp;
    constexpr int NU = NB * 6 * SC_NCH;
    LAS unsigned short* S0 = (LAS unsigned short*)(hl + 35840); LAS unsigned short* S1 = S0 + 4608;
    LAS float* CW = (LAS float*)(lds + 2 * SC_HALF - 27648);
    if constexpr (GRP == 0) { for (int i = tix; i < 2 * 16 * 192 + 2 * 192; i += 512) CW[i] = i < 6144 ? A.wa2[i] : A.ba[i - 6144]; }
    const int tr = tid2 >> 3, o = tid2 & 7, t4 = tid2 >> 2, o4 = tid2 & 3;
    v4u ld0, ld1, ld2, ld3, ld4, ld5; int n, bh, h; size_t row0; bool active;
#define P1_UNIT(base_) do { const int unit_ = (base_) + 2 * (int)blockIdx.x + half; active = unit_ < NU; const int u_ = active ? NU - 1 - unit_ : 0;     h = u_ % 6; n = (u_ / 6) % SC_NCH; bh = (u_ / (6 * SC_NCH)) * 6 + h; row0 = (size_t)(bh / 6) * SEQ_ + (size_t)n * 64; } while (0)
#define P1_LOAD() do { const pt* pr0 = A.proj + (row0 + tr) * NPS; const pt* pr1 = pr0 + (size_t)32 * NPS; ld0 = *(const v4u*)(pr0 + CV + h * 64 + 8 * o); ld1 = *(const v4u*)(pr1 + CV + h * 64 + 8 * o); \
        if constexpr (GRP == 1) { ld2 = *(const v4u*)(pr0 + C_HF + h * 64 + 8 * o); ld3 = *(const v4u*)(pr1 + C_HF + h * 64 + 8 * o); ld4 = *(const v4u*)(pr0 + C_HF + 384 + h * 64 + 8 * o); ld5 = *(const v4u*)(pr1 + C_HF + 384 + h * 64 + 8 * o); } \
        else { const pt* pq = A.proj + (row0 + t4) * NPS; ld2 = *(const v4u*)(pq + C_GK + h * 32 + 8 * o4); ld3 = *(const v4u*)(pq + C_GA + 8 * o4); } } while (0)
    P1_UNIT(0); P1_LOAD();
    LDS_BARRIER();
    for (int base = 0; base < NU; base += 2 * (int)gridDim.x) {
        const int cn = n, cbh = bh, ch = h; const size_t crow0 = row0; const bool cactive = active;
        GateRaw<GRP> rf[SL], rb[SL];
        { if constexpr (GRP == 1) { *(LAS v4u*)(S0 + tr * 72 + 8 * o) = ld2; *(LAS v4u*)(S0 + (tr + 32) * 72 + 8 * o) = ld3; *(LAS v4u*)(S1 + tr * 72 + 8 * o) = ld4; *(LAS v4u*)(S1 + (tr + 32) * 72 + 8 * o) = ld5; }
          else { *(LAS v4u*)(S0 + t4 * 40 + 8 * o4) = ld2; *(LAS v4u*)(S1 + t4 * 40 + 8 * o4) = ld3; }
          const v4u vv0 = ld0, vv1 = ld1;
#pragma unroll
          for (int i = 0; i < 4; ++i) { VT[(8 * o + 2 * i) * 72 + tr] = (unsigned short)(vv0[i] & 0xffffu); VT[(8 * o + 2 * i + 1) * 72 + tr] = (unsigned short)(vv0[i] >> 16);
              VT[(8 * o + 2 * i) * 72 + tr + 32] = (unsigned short)(vv1[i] & 0xffffu); VT[(8 * o + 2 * i + 1) * 72 + tr + 32] = (unsigned short)(vv1[i] >> 16); }
          LDS_BARRIER();
#pragma unroll
          for (int m = 0; m < SL; ++m) { const int t = seg * SL + m;
              if constexpr (GRP == 1) { rf[m].kw = *(const LAS unsigned*)(S0 + t * 72 + k2); rb[m].kw = *(const LAS unsigned*)(S1 + t * 72 + k2); }
              else { rf[m].kw = *(const LAS unsigned*)(S0 + t * 40 + k2); rb[m].kw = rf[m].kw; rf[m].a0 = *(const LAS v4u*)(S1 + t * 40); rf[m].a1 = *(const LAS v4u*)(S1 + t * 40 + 8); rb[m].a0 = *(const LAS v4u*)(S1 + t * 40 + 16); rb[m].a1 = *(const LAS v4u*)(S1 + t * 40 + 24); } }
        }
        float kf[SL][2], kbk[SL][2], gf[SL][2], gb[SL][2];
        { GateCtx cx; P1_CTX(0);
#pragma unroll
          for (int m = 0; m < SL; ++m) sc_gate<GRP>(cx, rf[m], gf[m], kf[m]);
          P1_CTX(1);
#pragma unroll
          for (int m = 0; m < SL; ++m) sc_gate<GRP>(cx, rb[m], gb[m], kbk[m]); }
        if constexpr (GRP == 0) { if (cactive) {
#pragma unroll
            for (int m = 0; m < SL; ++m) { const size_t row = crow0 + seg * SL + m; *(unsigned*)(A.AL + row * 192 + ch * 32 + k2) = cvtpk(gf[m][0], gf[m][1]); *(unsigned*)(A.AL + ((size_t)T + row) * 192 + ch * 32 + k2) = cvtpk(gb[m][0], gb[m][1]); } } }
        float ef[SL][2], eb[SL][2], tf[2] = {0.f, 0.f}, tb[2] = {0.f, 0.f};
#pragma unroll
        for (int m = SL - 1; m >= 0; --m) { ef[m][0] = tf[0]; ef[m][1] = tf[1]; tf[0] += gf[m][0]; tf[1] += gf[m][1]; }
#pragma unroll
        for (int m = 0; m < SL; ++m) { eb[m][0] = tb[0]; eb[m][1] = tb[1]; tb[0] += gb[m][0]; tb[1] += gb[m][1]; }
        TOT0[seg * KP + kp] = (f32x2){tf[0], tf[1]}; TOT1[seg * KP + kp] = (f32x2){tb[0], tb[1]};
        LDS_BARRIER();
        float af[2] = {0.f, 0.f}, ab[2] = {0.f, 0.f}, allf[2] = {0.f, 0.f}, allb[2] = {0.f, 0.f};
#pragma unroll
        for (int s2 = 0; s2 < NSEG; ++s2) { const f32x2 a = TOT0[s2 * KP + kp], c = TOT1[s2 * KP + kp]; allf[0] += a[0]; allf[1] += a[1]; allb[0] += c[0]; allb[1] += c[1];
            if (s2 > seg) { af[0] += a[0]; af[1] += a[1]; } if (s2 < seg) { ab[0] += c[0]; ab[1] += c[1]; } }
#pragma unroll
        for (int j = 0; j < 2; ++j)
#pragma unroll
            for (int m = 0; m < SL; m += 2) { const int t = seg * SL + m;
                *(LAS unsigned*)(KT0 + (k2 + j) * 72 + t) = cvtpk(kf[m][j] * __expf(af[j] + ef[m][j]), kf[m + 1][j] * __expf(af[j] + ef[m + 1][j]));
                *(LAS unsigned*)(KT1 + (k2 + j) * 72 + t) = cvtpk(kbk[m][j] * __expf(ab[j] + eb[m][j]), kbk[m + 1][j] * __expf(ab[j] + eb[m + 1][j])); }
        if (seg == 0 && cactive) { const size_t sd = (size_t)cbh * 2; *(f32x2*)(A.DD + ((sd + 0) * SC_NCH + cn) * K + k2) = (f32x2){__expf(allf[0]), __expf(allf[1])}; *(f32x2*)(A.DD + ((sd + 1) * SC_NCH + cn) * K + k2) = (f32x2){__expf(allb[0]), __expf(allb[1])}; }
        LDS_BARRIER();
        if (base + 2 * (int)gridDim.x < NU) { P1_UNIT(base + 2 * (int)gridDim.x); P1_LOAD(); }
        __builtin_amdgcn_sched_barrier(0);
#pragma unroll
        for (int d = 0; d < 2; ++d) { const LAS unsigned short* KTd = d ? KT1 : KT0; pt* dsu = A.DS + (((size_t)cbh * 2 + d) * SC_NCH + cn) * (size_t)(64 * K);
#pragma unroll
            for (int kb = 0; kb < K / 16; ++kb) { f32x4 acc = {0.f, 0.f, 0.f, 0.f};
#pragma unroll
                for (int kk = 0; kk < 2; ++kk) { const sbf16x8 af8 = *(const LAS sbf16x8*)(KTd + (16 * kb + r) * 72 + 32 * kk + 8 * g4), bfr = *(const LAS sbf16x8*)(VT + (16 * w4 + r) * 72 + 32 * kk + 8 * g4);
                    acc = __builtin_amdgcn_mfma_f32_16x16x32_bf16(af8, bfr, acc, 0, 0, 0); }
                if (cactive) { v2u o; o.x = cvtpk(acc[0], acc[1]); o.y = cvtpk(acc[2], acc[3]); *(v2u*)(dsu + (size_t)(16 * w4 + r) * K + 16 * kb + 4 * g4) = o; } } }
        LDS_BARRIER();
    }
}
#undef P1_UNIT
#undef P1_LOAD
#undef P1_CTX

__device__ __forceinline__ void scan_p2(pt* DS_gla, float* DD_gla, pt* DS_hg, float* DD_hg, size_t id) {
    const bool hg = id < (size_t)NB * 6 * 2 * 1024; const int K = hg ? 64 : 32; const size_t i2 = hg ? id : id - (size_t)NB * 6 * 2 * 1024;
    const int per = 64 * K / 4; const int sd = (int)(i2 / per), rem = (int)(i2 % per), v = rem / (K / 4), kq = rem % (K / 4), d = sd & 1;
    pt* ds = (hg ? DS_hg : DS_gla) + (size_t)sd * SC_NCH * 64 * K + (size_t)v * K + 4 * kq; const float* dd = (hg ? DD_hg : DD_gla) + (size_t)sd * SC_NCH * K + 4 * kq;
    float S0 = 0.f, S1 = 0.f, S2 = 0.f, S3 = 0.f;
    for (int nb = 0; nb < SC_NCH; nb += 8) {
        v2u dv[8]; f32x4 de[8];
#pragma unroll
        for (int j = 0; j < 8; ++j) { const int nn = nb + j, n = d ? SC_NCH - 1 - nn : nn; dv[j] = *(const v2u*)(ds + (size_t)n * 64 * K); de[j] = *(const f32x4*)(dd + (size_t)n * K); }
#pragma unroll
        for (int j = 0; j < 8; ++j) { const int nn = nb + j, n = d ? SC_NCH - 1 - nn : nn;
            v2u o; o.x = cvtpk(S0, S1); o.y = cvtpk(S2, S3); *(v2u*)(ds + (size_t)n * 64 * K) = o;
            S0 = de[j][0] * S0 + __uint_as_float(dv[j].x << 16); S1 = de[j][1] * S1 + __uint_as_float(dv[j].x & 0xffff0000u); S2 = de[j][2] * S2 + __uint_as_float(dv[j].y << 16); S3 = de[j][3] * S3 + __uint_as_float(dv[j].y & 0xffff0000u); }
    }
}
template <int GRP> __device__ __forceinline__ void scan_p3(LAS unsigned char* lds, const ScanP A, int wv_) {
    constexpr int K = GRP ? 64 : 32, KS = K + 8, KP = K / 2, NSEG = 256 / KP, SL = 64 / NSEG, SPB = NSEG / 4, CV = GRP ? C_HI : C_GV, CGATE = GRP ? C_HGT : C_GG, COUT = GRP ? 384 : 0;
    const int tix = opaque_tid(), half = tix >> 8, tid2 = tix & 255, lane = tix & 63, w4 = __builtin_amdgcn_readfirstlane((tix >> 6) & 3), r = lane & 15, g4 = lane >> 4;
    LAS unsigned char* hl = lds + half * SC_HALF;
    LAS f32x2* TOT = (LAS f32x2*)hl;
    LAS unsigned short* AM = (LAS unsigned short*)(hl + 4096);
    LAS unsigned short* KH = AM + 4 * 4608; LAS unsigned short* KT = AM + 5 * 4608; LAS unsigned short* VT = AM + 6 * 4608;
    LAS unsigned short* PS = AM; LAS unsigned short* YS = AM + 4608;
    const int kp = tid2 % KP, seg = tid2 / KP, k2 = 2 * kp, I = seg / SPB;
    constexpr int NU = NB * 6 * SC_NCH;
    unsigned qw[SL], vw[8]; typedef typename std::conditional<GRP == 0, GateLite, GateRaw<1>>::type GR; GR rg[SL]; sbf16x8 sf[K / 32][4]; v4u gv[2];
    int n, bh, h; size_t row0; bool active;
    LAS float* GN = (LAS float*)(hl + 2048);
    for (int i = tid2; i < 384; i += 256) GN[i] = A.gain[i];
#define SC_UNIT(base_) do { const int unit_ = (base_) + 2 * (int)blockIdx.x + half; active = unit_ < NU; const int u_ = active ? unit_ : 0; h = u_ % 6; n = (u_ / 6) % SC_NCH; bh = (u_ / (6 * SC_NCH)) * 6 + h; row0 = (size_t)(bh / 6) * SEQ_ + (size_t)n * 64; } while (0)
#define SC_LOAD_SF(d_) do { const pt* st_ = A.DS + (((size_t)bh * 2 + (d_)) * SC_NCH + n) * (size_t)(64 * K); _Pragma("unroll") for (int kk = 0; kk < K / 32; ++kk) _Pragma("unroll") for (int vb = 0; vb < 4; ++vb) \
            sf[kk][vb] = *(const sbf16x8*)(st_ + (size_t)(16 * vb + r) * K + 32 * kk + 8 * g4); } while (0)
#define SC_LOAD_TOP() do { _Pragma("unroll") for (int m = 0; m < SL; ++m) { qw[m] = sc_q_load<GRP>(A, row0 + seg * SL + m, h, k2); if constexpr (GRP == 0) sc_lite_load(A, row0 + seg * SL + m, h, k2, 0, (GateLite&)rg[m]); else sc_gate_load<1>(A, row0 + seg * SL + m, h, k2, 0, (GateRaw<1>&)rg[m]); } \
            sc_vt_load(vw, A.proj, row0, CV + h * 64, tid2); } while (0)
    SC_UNIT(0); SC_LOAD_TOP(); __builtin_amdgcn_sched_barrier(0);
    for (int base = 0; base < NU; base += 2 * (int)gridDim.x) {
        const size_t crow0 = row0; const int ch = h; const bool cactive = active;
        SC_LOAD_SF(0);
        __builtin_amdgcn_sched_barrier(0);
        unsigned qp[SL];
#pragma unroll
        for (int m = 0; m < SL; ++m) { float qf[2]; sc_q<GRP>(qw[m], qf); qp[m] = cvtpk(qf[0], qf[1]); }
        sc_vt_store(VT, vw, tid2);
        f32x4 P[4], O[4];
#pragma unroll
        for (int j = 0; j < 4; ++j) { P[j] = (f32x4){0.f, 0.f, 0.f, 0.f}; O[j] = (f32x4){0.f, 0.f, 0.f, 0.f}; }
#pragma unroll
        for (int d = 0; d < 2; ++d) {
            float u[SL][2], w[SL][2], tot[2] = {0.f, 0.f};
            { float eg[SL][2];
#pragma unroll
              for (int m = 0; m < SL; ++m) { float g_[2], kf_[2];
                  if constexpr (GRP == 0) { sc_lite((const GateLite&)rg[m], g_, kf_); eg[m][0] = __builtin_amdgcn_exp2f(1.4426950408889634f * g_[0]); eg[m][1] = __builtin_amdgcn_exp2f(1.4426950408889634f * g_[1]); }
                  else { const unsigned kw_ = ((const GateRaw<1>&)rg[m]).kw; g_[0] = __uint_as_float(kw_ << 16); g_[1] = __uint_as_float(kw_ & 0xffff0000u); eg[m][0] = __builtin_amdgcn_exp2f(1.4426950408889634f * g_[0]); eg[m][1] = __builtin_amdgcn_exp2f(1.4426950408889634f * g_[1]); kf_[0] = 1.0f - eg[m][0]; kf_[1] = 1.0f - eg[m][1]; }
                  tot[0] += g_[0]; tot[1] += g_[1]; w[m][0] = kf_[0]; w[m][1] = kf_[1]; }
              float r1[2] = {1.f, 1.f}, r2[2] = {1.f, 1.f};
#pragma unroll
              for (int mm = 0; mm < SL; ++mm) { const int m = d == 0 ? mm : SL - 1 - mm;
#pragma unroll
                  for (int j = 0; j < 2; ++j) { r1[j] *= eg[m][j]; u[m][j] = (j ? __uint_as_float(qp[m] & 0xffff0000u) : __uint_as_float(qp[m] << 16)) * r1[j]; } }
#pragma unroll
              for (int mm = SL - 1; mm >= 0; --mm) { const int m = d == 0 ? mm : SL - 1 - mm;
#pragma unroll
                  for (int j = 0; j < 2; ++j) { w[m][j] *= r2[j]; r2[j] *= eg[m][j]; } } }
            if (d == 0) {
#pragma unroll
                for (int m = 0; m < SL; ++m) { if constexpr (GRP == 0) sc_lite_load(A, row0 + seg * SL + m, h, k2, 1, (GateLite&)rg[m]); else sc_gate_load<1>(A, row0 + seg * SL + m, h, k2, 1, (GateRaw<1>&)rg[m]); } }
            TOT[seg * KP + kp] = (f32x2){tot[0], tot[1]};
            LDS_BARRIER();
            float Pr[5][2], bs[2] = {0.f, 0.f};
            { float run[2] = {0.f, 0.f}; Pr[0][0] = 0.f; Pr[0][1] = 0.f;
#pragma unroll
              for (int s3 = 0; s3 < NSEG; ++s3) { const int s2 = d == 0 ? s3 : NSEG - 1 - s3; const f32x2 a = TOT[s2 * KP + kp];
                  if (s2 == seg) { bs[0] = run[0]; bs[1] = run[1]; }
                  run[0] += a[0]; run[1] += a[1];
                  if ((s3 % SPB) == SPB - 1) { Pr[s3 / SPB + 1][0] = run[0]; Pr[s3 / SPB + 1][1] = run[1]; } } }
            const int Iv = d == 0 ? I : 3 - I;
            float rp[2], ro[2], M1[2], M2[2], M3[2], FH[2];
#pragma unroll
            for (int j = 0; j < 2; ++j) { float rb1 = 0.f, rb2 = 0.f, rb3 = 0.f; rp[j] = 0.f; ro[j] = 0.f;
#pragma unroll
                for (int x = 0; x < 4; ++x) { if (Iv == x) { rp[j] = Pr[x][j]; ro[j] = Pr[x + 1][j]; rb1 = Pr[x > 0 ? x - 1 : 0][j]; rb2 = Pr[x > 1 ? x - 2 : 0][j]; rb3 = Pr[x > 2 ? x - 3 : 0][j]; } }
                M1[j] = __expf(rp[j] - rb1); M2[j] = __expf(rp[j] - rb2); M3[j] = __expf(rp[j] - rb3); FH[j] = __expf(fminf(rp[j] - ro[j], 80.f)); }
            float E0[2], EE[2];
#pragma unroll
            for (int j = 0; j < 2; ++j) { E0[j] = __expf(bs[j] - rp[j]); EE[j] = __expf(ro[j] - bs[j] - tot[j]); }
#pragma unroll
            for (int m = 0; m < SL; ++m) { const int t = seg * SL + m; float a0[2], kt[2];
#pragma unroll
                for (int j = 0; j < 2; ++j) { a0[j] = u[m][j] * E0[j]; kt[j] = w[m][j] * EE[j]; }
                LAS unsigned short* ap = AM + t * KS + k2;
                *(LAS unsigned*)(ap) = cvtpk(a0[0], a0[1]); *(LAS unsigned*)(ap + 4608) = cvtpk(a0[0] * M1[0], a0[1] * M1[1]);
                *(LAS unsigned*)(ap + 2 * 4608) = cvtpk(a0[0] * M2[0], a0[1] * M2[1]); *(LAS unsigned*)(ap + 3 * 4608) = cvtpk(a0[0] * M3[0], a0[1] * M3[1]);
                *(LAS unsigned*)(KT + t * KS + k2) = cvtpk(kt[0], kt[1]); *(LAS unsigned*)(KH + t * KS + k2) = cvtpk(kt[0] * FH[0], kt[1] * FH[1]); }
            LDS_BARRIER();
            { const int Iw = w4; const int lvi = d == 0 ? Iw : 3 - Iw;
              const LAS unsigned short* ai = AM + lvi * 4608 + (16 * Iw + r) * KS + 8 * g4;
#pragma unroll
              for (int kk = 0; kk < K / 32; ++kk) { const sbf16x8 af = *(const LAS sbf16x8*)(ai + 32 * kk);
#pragma unroll
                  for (int vb = 0; vb < 4; ++vb) O[vb] = __builtin_amdgcn_mfma_f32_16x16x32_bf16(af, sf[kk][vb], O[vb], 0, 0, 0); }
#pragma unroll
              for (int J = 0; J < 4; ++J) {
                  if (J == Iw) { f32x4 tm = {0.f, 0.f, 0.f, 0.f};
#pragma unroll
                      for (int kk = 0; kk < K / 32; ++kk) { const sbf16x8 af = *(const LAS sbf16x8*)(AM + (16 * Iw + r) * KS + 32 * kk + 8 * g4), bfr = *(const LAS sbf16x8*)(KH + (16 * J + r) * KS + 32 * kk + 8 * g4);
                          tm = __builtin_amdgcn_mfma_f32_16x16x32_bf16(af, bfr, tm, 0, 0, 0); }
#pragma unroll
                      for (int e = 0; e < 4; ++e) { const int tl = 4 * g4 + e; const bool keep = d == 0 ? (r <= tl) : (r >= tl); P[J][e] += keep ? tm[e] : 0.f; } }
                  else if ((d == 0 && J < Iw) || (d == 1 && J > Iw)) { const int lv = (d == 0 ? Iw - J : J - Iw) - 1;
#pragma unroll
                      for (int kk = 0; kk < K / 32; ++kk) { const sbf16x8 af = *(const LAS sbf16x8*)(AM + lv * 4608 + (16 * Iw + r) * KS + 32 * kk + 8 * g4), bfr = *(const LAS sbf16x8*)(KT + (16 * J + r) * KS + 32 * kk + 8 * g4);
                          P[J] = __builtin_amdgcn_mfma_f32_16x16x32_bf16(af, bfr, P[J], 0, 0, 0); } }
              } }
            if (d == 0) { SC_LOAD_SF(1); __builtin_amdgcn_sched_barrier(0); }
            else {
#pragma unroll
                for (int j = 0; j < 2; ++j) { const int it = tid2 + 256 * j, t = it >> 3, v8 = (it & 7) * 8; gv[j] = *(const v4u*)(A.proj + (row0 + t) * NPS + CGATE + h * 64 + v8); }
                if (base + 2 * (int)gridDim.x < NU) { SC_UNIT(base + 2 * (int)gridDim.x); SC_LOAD_TOP(); }
                __builtin_amdgcn_sched_barrier(0); }
            LDS_BARRIER();
        }
#pragma unroll
        for (int J = 0; J < 4; ++J)
#pragma unroll
            for (int e = 0; e < 4; ++e) PS[(16 * w4 + 4 * g4 + e) * 72 + 16 * J + r] = (unsigned short)(cvtpk(P[J][e], P[J][e]) & 0xffffu);
        LDS_BARRIER();
#pragma unroll
        for (int kk = 0; kk < 2; ++kk) { const sbf16x8 af = *(const LAS sbf16x8*)(PS + (16 * w4 + r) * 72 + 32 * kk + 8 * g4);
#pragma unroll
            for (int vb = 0; vb < 4; ++vb) { const sbf16x8 bfr = *(const LAS sbf16x8*)(VT + (16 * vb + r) * 72 + 32 * kk + 8 * g4); O[vb] = __builtin_amdgcn_mfma_f32_16x16x32_bf16(af, bfr, O[vb], 0, 0, 0); } }
        float rs[4];
#pragma unroll
        for (int e = 0; e < 4; ++e) { float ss = O[0][e] * O[0][e] + O[1][e] * O[1][e] + O[2][e] * O[2][e] + O[3][e] * O[3][e];
            ss = rowsum16(ss); rs[e] = rsqrtf(ss * (1.0f / 64.0f) + RMS_EPS); }
#pragma unroll
        for (int vb = 0; vb < 4; ++vb)
#pragma unroll
            for (int e = 0; e < 4; ++e) YS[(16 * w4 + 4 * g4 + e) * 72 + 16 * vb + r] = (unsigned short)(cvtpk(O[vb][e] * rs[e], 0.f) & 0xffffu);
        LDS_BARRIER();
#pragma unroll
        for (int j = 0; j < 2; ++j) { const int it = tid2 + 256 * j, t = it >> 3, v8 = (it & 7) * 8;
            const v4u yv = *(const LAS v4u*)(YS + t * 72 + v8); const f32x4 gn0 = *(const LAS f32x4*)(GN + ch * 64 + v8), gn1 = *(const LAS f32x4*)(GN + ch * 64 + v8 + 4);
            float o[8];
#pragma unroll
            for (int e = 0; e < 8; ++e) { const unsigned yw = yv[e >> 1], gw = gv[j][e >> 1]; const float yf = __uint_as_float((e & 1) ? (yw & 0xffff0000u) : (yw << 16)), gf = __uint_as_float((e & 1) ? (gw & 0xffff0000u) : (gw << 16));
                o[e] = yf * (e < 4 ? gn0[e] : gn1[e - 4]) * gf; }
            if (cactive) { v4u ov; ov.x = cvtpk(o[0], o[1]); ov.y = cvtpk(o[2], o[3]); ov.z = cvtpk(o[4], o[5]); ov.w = cvtpk(o[6], o[7]);
                *(v4u*)(A.mixin + (crow0 + t) * (size_t)A.ms + COUT + ch * 64 + v8) = ov; } }
        LDS_BARRIER();
    }
}
#undef SC_UNIT
#undef SC_LOAD_SF
#undef SC_LOAD_TOP

__device__ __forceinline__ float wsum(float v) { v = rowsum16(v); return (rdlane(v, 0) + rdlane(v, 16)) + (rdlane(v, 32) + rdlane(v, 48)); }
__device__ __forceinline__ float bfl(unsigned w) { return __uint_as_float(w << 16); }
__device__ __forceinline__ float bfh(unsigned w) { return __uint_as_float(w & 0xffff0000u); }
struct LnGB { f32x4 g[4], b[4]; };
__device__ __forceinline__ LnGB ln_gb(const float* g, const float* be, int lane) { LnGB r;
#pragma unroll
    for (int j = 0; j < 4; ++j) { r.g[j] = *(const f32x4*)(g + 256 * j + 4 * lane); r.b[j] = *(const f32x4*)(be + 256 * j + 4 * lane); }
    return r; }
__device__ __forceinline__ void ln_finish(f32x4 (&v)[4], const LnGB& gb, float* hrow, pt* xrow, int lane) {
    float s = 0.f;
#pragma unroll
    for (int j = 0; j < 4; ++j) s += (v[j][0] + v[j][1]) + (v[j][2] + v[j][3]);
    const float mean = wsum(s) * (1.0f / DM); float q = 0.f;
#pragma unroll
    for (int j = 0; j < 4; ++j) { v[j] = v[j] - mean; q += (v[j][0] * v[j][0] + v[j][1] * v[j][1]) + (v[j][2] * v[j][2] + v[j][3] * v[j][3]); }
    const float rstd = 1.0f / sqrtf(wsum(q) * (1.0f / DM) + LN_EPS);
#pragma unroll
    for (int j = 0; j < 4; ++j) {
        v[j] = v[j] * rstd * gb.g[j] + gb.b[j]; if (hrow) *(f32x4*)(hrow + 256 * j + 4 * lane) = v[j];
        if (xrow) { v2u o; o.x = cvtpk(v[j][0], v[j][1]); o.y = cvtpk(v[j][2], v[j][3]); *(v2u*)(xrow + 256 * j + 4 * lane) = o; } }
}
__device__ __forceinline__ void ln_finish_l(f32x4 (&v)[4], const LAS float* gl, float* hrow, pt* xrow, int lane) {
    float s = 0.f;
#pragma unroll
    for (int j = 0; j < 4; ++j) s += (v[j][0] + v[j][1]) + (v[j][2] + v[j][3]);
    const float mean = wsum(s) * (1.0f / DM); float q = 0.f;
#pragma unroll
    for (int j = 0; j < 4; ++j) { v[j] = v[j] - mean; q += (v[j][0] * v[j][0] + v[j][1] * v[j][1]) + (v[j][2] * v[j][2] + v[j][3] * v[j][3]); }
    const float rstd = 1.0f / sqrtf(wsum(q) * (1.0f / DM) + LN_EPS);
#pragma unroll
    for (int j = 0; j < 4; ++j) {
        v[j] = v[j] * rstd * *(const LAS f32x4*)(gl + 256 * j + 4 * lane) + *(const LAS f32x4*)(gl + 1024 + 256 * j + 4 * lane); if (hrow) *(f32x4*)(hrow + 256 * j + 4 * lane) = v[j];
        if (xrow) { v2u o; o.x = cvtpk(v[j][0], v[j][1]); o.y = cvtpk(v[j][2], v[j][3]); *(v2u*)(xrow + 256 * j + 4 * lane) = o; } }
}
template <int NW = 8, int U = 2> __device__ __forceinline__ void ew_ln_in(const float* x, const float* g, const float* be, float* H, pt* XB, int wv_) {
    const int tix = opaque_tid(), lane = tix & 63; const int gw = (tix >> 6) * gridDim.x + blockIdx.x, NGW = gridDim.x * NW;
    const LnGB gb = ln_gb(g, be, lane);
    f32x4 nx[U][4];
#pragma unroll
    for (int u = 0; u < U; ++u) if (gw + u * NGW < T) {
#pragma unroll
        for (int j = 0; j < 4; ++j) nx[u][j] = *(const f32x4*)(x + (size_t)(gw + u * NGW) * DM + 256 * j + 4 * lane); }
    for (int row0 = gw; row0 < T; row0 += U * NGW) {
#pragma unroll
        for (int u = 0; u < U; ++u) { const int row = row0 + u * NGW; if (row < T) { f32x4 v[4];
#pragma unroll
            for (int j = 0; j < 4; ++j) v[j] = nx[u][j];
            if (row + U * NGW < T) {
#pragma unroll
                for (int j = 0; j < 4; ++j) nx[u][j] = *(const f32x4*)(x + (size_t)(row + U * NGW) * DM + 256 * j + 4 * lane); }
            ln_finish(v, gb, H ? H + (size_t)row * DM : nullptr, XB + (size_t)row * DM, lane); } } }
}
template <bool MIXBF, bool RESBF = false, int U = 2> __device__ __forceinline__ void ew_ln1_route(LAS unsigned char* lds, const void* Hres, float* H, const void* MIXv, const float* g, const float* be, pt* XB,
        const float* wrg, const float* brg, const float* wre, const float* bre, int* RE, float* RW, int* CNT, int wv_) {
    const int tix = opaque_tid(), lane = tix & 63, wave = tix >> 6; const int gw = wave * gridDim.x + blockIdx.x, NGW = gridDim.x * 8;
    LAS f32x4* TG = (LAS f32x4*)lds;
    LAS f32x4* TE = (LAS f32x4*)(lds + 16384);
    LAS int* LC = (LAS int*)(lds + 16384 + 65536);
    for (int i = tix; i < 1024; i += 512) { const int c = i; const int j = c >> 8, ln = (c & 255) >> 2, e = c & 3, slot = (j * 4 + e) * 64 + ln;
        TG[slot] = *(const f32x4*)(wrg + (size_t)c * 4);
#pragma unroll
        for (int gi = 0; gi < 4; ++gi) TE[gi * 1024 + slot] = *(const f32x4*)(wre + (size_t)c * 16 + gi * 4); }
    LAS float* TB = (LAS float*)(lds + 16384 + 65536 + 64);
    if (tix < 16) { LC[tix] = 0; TB[tix] = bre[tix]; }
    __syncthreads();
    const f32x4 bg = *(const f32x4*)brg; const LnGB gb = ln_gb(g, be, lane);
    f32x4 nh[U][4]; v2u nhb[U][4]; v2u nm[U][4]; f32x4 nmf[U][4];
#define LN1_LOAD(u_, r_) do { _Pragma("unroll") for (int j = 0; j < 4; ++j) { if constexpr (RESBF) nhb[u_][j] = *(const v2u*)((const pt*)Hres + (size_t)(r_) * DM + 256 * j + 4 * lane); else nh[u_][j] = *(const f32x4*)((const float*)Hres + (size_t)(r_) * DM + 256 * j + 4 * lane); \
        if constexpr (MIXBF) nm[u_][j] = *(const v2u*)((const pt*)MIXv + (size_t)(r_) * DM + 256 * j + 4 * lane); else nmf[u_][j] = *(const f32x4*)((const float*)MIXv + (size_t)(r_) * DM + 256 * j + 4 * lane); } } while (0)
#pragma unroll
    for (int u = 0; u < U; ++u) if (gw + u * NGW < T) LN1_LOAD(u, gw + u * NGW);
    for (int row0 = gw; row0 < T; row0 += U * NGW)
#pragma unroll
    for (int u = 0; u < U; ++u) { const int row = row0 + u * NGW; if (row >= T) break; f32x4 v[4];
#pragma unroll
        for (int j = 0; j < 4; ++j) { f32x4 mx;
            if constexpr (MIXBF) mx = (f32x4){bfl(nm[u][j].x), bfh(nm[u][j].x), bfl(nm[u][j].y), bfh(nm[u][j].y)}; else mx = nmf[u][j];
            f32x4 hr; if constexpr (RESBF) hr = (f32x4){bfl(nhb[u][j].x), bfh(nhb[u][j].x), bfl(nhb[u][j].y), bfh(nhb[u][j].y)}; else hr = nh[u][j];
            v[j] = hr * ALPHA + mx; }
        if (row + U * NGW < T) LN1_LOAD(u, row + U * NGW);
        ln_finish(v, gb, H ? H + (size_t)row * DM : nullptr, XB + (size_t)row * DM, lane);
        f32x4 lg = {0.f, 0.f, 0.f, 0.f};
#pragma unroll
        for (int j = 0; j < 4; ++j)
#pragma unroll
            for (int e = 0; e < 4; ++e) lg += TG[(j * 4 + e) * 64 + lane] * v[j][e];
        lg[0] = wsum(lg[0]) + bg[0]; lg[1] = wsum(lg[1]) + bg[1]; lg[2] = wsum(lg[2]) + bg[2]; lg[3] = wsum(lg[3]) + bg[3];
        int gi = 0; float gm = lg[0];
        if (lg[1] > gm) { gm = lg[1]; gi = 1; } if (lg[2] > gm) { gm = lg[2]; gi = 2; } if (lg[3] > gm) { gm = lg[3]; gi = 3; }
        gi = __builtin_amdgcn_readfirstlane(gi);
        const float gval = __builtin_amdgcn_rcpf(__expf(lg[0] - gm) + __expf(lg[1] - gm) + __expf(lg[2] - gm) + __expf(lg[3] - gm));
        f32x4 le = {0.f, 0.f, 0.f, 0.f};
#pragma unroll
        for (int j = 0; j < 4; ++j)
#pragma unroll
            for (int e = 0; e < 4; ++e) le += TE[gi * 1024 + (j * 4 + e) * 64 + lane] * v[j][e];
        const f32x4 bev = *(const LAS f32x4*)(TB + gi * 4);
        le[0] = wsum(le[0]) + bev[0]; le[1] = wsum(le[1]) + bev[1]; le[2] = wsum(le[2]) + bev[2]; le[3] = wsum(le[3]) + bev[3];
        int e0 = 0; float v0 = le[0];
        if (le[1] > v0) { v0 = le[1]; e0 = 1; } if (le[2] > v0) { v0 = le[2]; e0 = 2; } if (le[3] > v0) { v0 = le[3]; e0 = 3; }
        int e1 = -1; float v1 = -3.0e38f;
        if (e0 != 0 && le[0] > v1) { v1 = le[0]; e1 = 0; } if (e0 != 1 && le[1] > v1) { v1 = le[1]; e1 = 1; }
        if (e0 != 2 && le[2] > v1) { v1 = le[2]; e1 = 2; } if (e0 != 3 && le[3] > v1) { v1 = le[3]; e1 = 3; }
        const float p1 = __expf(v1 - v0), w0 = __builtin_amdgcn_rcpf(1.0f + p1), w1 = p1 * w0;
        if (lane == 0) { RE[row * 2] = gi * 4 + e0; RE[row * 2 + 1] = gi * 4 + e1; RW[row * 2] = gval * w0; RW[row * 2 + 1] = gval * w1;
            __hip_atomic_fetch_add(LC + gi * 4 + e0, 1, __ATOMIC_RELAXED, __HIP_MEMORY_SCOPE_WORKGROUP); __hip_atomic_fetch_add(LC + gi * 4 + e1, 1, __ATOMIC_RELAXED, __HIP_MEMORY_SCOPE_WORKGROUP); }
    }
#undef LN1_LOAD
    __syncthreads();
    if (tix < 16) { const int c = LC[tix]; if (c) atomicAdd(CNT + tix, c); }
    __syncthreads();
}
__device__ __forceinline__ void ew_assign_gather(LAS unsigned char* lds, const int* RE, const int* CNT, int* CUR, int* SLOT, const pt* XB, pt* XS, int wv_, int* TOKR = nullptr) {
    const int tix = opaque_tid(), lane = tix & 63, wave = tix >> 6;
    LAS int* LC = (LAS int*)lds; LAS int* LB_ = LC + 16; LAS int* PS_ = LC + 32; LAS int* SL = LC + 64;
    for (int g0 = blockIdx.x; g0 < T / 128; g0 += gridDim.x) {
        if (tix < 16) { LC[tix] = 0; int acc = 0; for (int e = 0; e < 16; ++e) { if (e == tix) PS_[tix] = acc; acc += (CNT[e] + 255) / 256 * 256; } }
        __syncthreads();
        int e = 0, rank = 0;
        if (tix < 256) { e = RE[g0 * 256 + tix]; rank = __hip_atomic_fetch_add(LC + e, 1, __ATOMIC_RELAXED, __HIP_MEMORY_SCOPE_WORKGROUP); }
        __syncthreads();
        if (tix < 16) LB_[tix] = LC[tix] ? atomicAdd(CUR + tix, LC[tix]) : 0;
        __syncthreads();
        if (tix < 256) { const int s = PS_[e] + LB_[e] + rank; SLOT[g0 * 256 + tix] = s; SL[tix] = s; if (TOKR) TOKR[s] = g0 * 128 + (tix >> 1); }
        __syncthreads();
        if (TOKR) continue;
        for (int a = wave; a < 256; a += 32) {
            v4u r0[4], r1[4];
#pragma unroll
            for (int q = 0; q < 4; ++q) { const int t = g0 * 128 + ((a + 8 * q) >> 1); const v4u* src = (const v4u*)(XB + (size_t)t * DM); r0[q] = src[lane]; r1[q] = src[lane + 64]; }
#pragma unroll
            for (int q = 0; q < 4; ++q) { const int s = SL[a + 8 * q]; v4u* dst = (v4u*)(XS + (size_t)s * DM); dst[lane] = r0[q]; dst[lane + 64] = r1[q]; } }
        __syncthreads();
    }
}
template <bool RESBF = false, int U = 2> __device__ __forceinline__ void ew_ln2(const void* Hres, float* H, const pt* Y, const int* SLOT, const float* RW, const float* g, const float* be, pt* XB, int wv_) {
    const int tix = opaque_tid(), lane = tix & 63; const int gw = (tix >> 6) * gridDim.x + blockIdx.x, NGW = gridDim.x * 8;
    const LnGB gb = ln_gb(g, be, lane);
    f32x4 nh[U][4]; v2u nhb[U][4]; v2u na[U][4], nb[U][4]; float nw0[U], nw1[U];
    int ps0[U], ps1[U]; float pw0[U], pw1[U];
#define LN2_IDX(u_, r_) do { ps0[u_] = SLOT[2 * (r_)]; ps1[u_] = SLOT[2 * (r_) + 1]; pw0[u_] = RW[2 * (r_)]; pw1[u_] = RW[2 * (r_) + 1]; } while (0)
#define LN2_LOAD(u_, r_) do { const int s0_ = ps0[u_], s1_ = ps1[u_]; nw0[u_] = pw0[u_]; nw1[u_] = pw1[u_]; _Pragma("unroll") for (int j = 0; j < 4; ++j) { \
        if constexpr (RESBF) nhb[u_][j] = *(const v2u*)((const pt*)Hres + (size_t)(r_) * DM + 256 * j + 4 * lane); else nh[u_][j] = *(const f32x4*)((const float*)Hres + (size_t)(r_) * DM + 256 * j + 4 * lane); na[u_][j] = *(const v2u*)(Y + (size_t)s0_ * DM + 256 * j + 4 * lane); nb[u_][j] = *(const v2u*)(Y + (size_t)s1_ * DM + 256 * j + 4 * lane); } } while (0)
#pragma unroll
    for (int u = 0; u < U; ++u) { nw0[u] = 0.f; nw1[u] = 0.f; ps0[u] = ps1[u] = 0; pw0[u] = pw1[u] = 0.f; if (gw + u * NGW < T) LN2_IDX(u, gw + u * NGW); }
#pragma unroll
    for (int u = 0; u < U; ++u) { if (gw + u * NGW < T) LN2_LOAD(u, gw + u * NGW); if (gw + (U + u) * NGW < T) LN2_IDX(u, gw + (U + u) * NGW); }
    for (int row0 = gw; row0 < T; row0 += U * NGW)
#pragma unroll
    for (int u = 0; u < U; ++u) { const int row = row0 + u * NGW; if (row >= T) break; f32x4 v[4]; const float w0 = nw0[u], w1 = nw1[u];
#pragma unroll
        for (int j = 0; j < 4; ++j) { const f32x4 ya = {bfl(na[u][j].x), bfh(na[u][j].x), bfl(na[u][j].y), bfh(na[u][j].y)}, yb = {bfl(nb[u][j].x), bfh(nb[u][j].x), bfl(nb[u][j].y), bfh(nb[u][j].y)};
            f32x4 hr; if constexpr (RESBF) hr = (f32x4){bfl(nhb[u][j].x), bfh(nhb[u][j].x), bfl(nhb[u][j].y), bfh(nhb[u][j].y)}; else hr = nh[u][j];
            v[j] = hr * ALPHA + (ya * w0 + yb * w1); }
        if (row + U * NGW < T) LN2_LOAD(u, row + U * NGW);
        if (row + 2 * U * NGW < T) LN2_IDX(u, row + 2 * U * NGW);
        ln_finish(v, gb, H ? H + (size_t)row * DM : nullptr, XB ? XB + (size_t)row * DM : nullptr, lane); }
#undef LN2_IDX
#undef LN2_LOAD
}
__device__ __forceinline__ void ew_hy_prep(LAS unsigned char* lds, const pt* proj, const float* cw, const float* cb, pt* u2t, int wv_) {
    const int tix = opaque_tid(); LAS unsigned short* TL = (LAS unsigned short*)lds;
    constexpr int NT = NB * (SEQ_ / 64) * 12;
    LAS float* CWL = (LAS float*)(lds + 16384);
    for (int i = tix; i < 4 * 768; i += 512) CWL[i] = i < 3 * 768 ? cw[i] : cb[i - 3 * 768];
    LDS_BARRIER();
    v4u pa = {0u, 0u, 0u, 0u}, pb = {0u, 0u, 0u, 0u};
#define PREP_LOAD(tile_) do { const int tr_ = NT - 1 - (tile_); const int c0_ = (tr_ % 12) * 64, t0_ = ((tr_ / 12) % (SEQ_ / 64)) * 64, b_ = tr_ / (12 * (SEQ_ / 64)); \
        { const int rr = tix >> 3, pc = tix & 7, t = t0_ - 1 + rr; pa = (v4u){0u, 0u, 0u, 0u}; if (t >= 0) pa = *(const v4u*)(proj + ((size_t)b_ * SEQ_ + t) * NPS + C_HY + c0_ + pc * 8); } \
        if (tix < 16) { const int rr = 64 + (tix >> 3), pc = tix & 7, t = t0_ - 1 + rr; pb = (v4u){0u, 0u, 0u, 0u}; if (t < SEQ_) pb = *(const v4u*)(proj + ((size_t)b_ * SEQ_ + t) * NPS + C_HY + c0_ + pc * 8); } } while (0)
    if ((int)blockIdx.x < NT) PREP_LOAD((int)blockIdx.x);
    for (int tile = blockIdx.x; tile < NT; tile += gridDim.x) {
        const int trv = NT - 1 - tile; const int c0 = (trv % 12) * 64, t0 = ((trv / 12) % (SEQ_ / 64)) * 64, b = trv / (12 * (SEQ_ / 64));
        *(LAS v4u*)(TL + (tix >> 3) * 72 + (tix & 7) * 8) = pa; if (tix < 16) *(LAS v4u*)(TL + (64 + (tix >> 3)) * 72 + (tix & 7) * 8) = pb;
        LDS_BARRIER();
        if (tile + (int)gridDim.x < NT) PREP_LOAD(tile + (int)gridDim.x);
        { const int cc = tix >> 3, t8 = tix & 7, c = c0 + cc; const float w0 = CWL[c], w1 = CWL[768 + c], w2 = CWL[1536 + c], bb = CWL[2304 + c];
          float x[10];
#pragma unroll
          for (int i = 0; i < 10; ++i) x[i] = __uint_as_float(((unsigned)TL[(8 * t8 + i) * 72 + cc]) << 16);
          unsigned o[4];
#pragma unroll
          for (int i = 0; i < 4; ++i) { const float a0 = bb + w0 * x[2 * i] + w1 * x[2 * i + 1] + w2 * x[2 * i + 2], a1 = bb + w0 * x[2 * i + 1] + w1 * x[2 * i + 2] + w2 * x[2 * i + 3]; o[i] = cvtpk(a0, a1); }
          *(v4u*)(u2t + ((size_t)b * 768 + c) * SEQ_ + t0 + 8 * t8) = (v4u){o[0], o[1], o[2], o[3]}; }
        LDS_BARRIER();
    }
#undef PREP_LOAD
}
__device__ __forceinline__ void ew_hy_tr(LAS unsigned char* lds, const pt* yt, pt* mixin, int ms, int wv_) {
    const int tix = opaque_tid(); LAS unsigned short* TL = (LAS unsigned short*)lds;
    constexpr int NT = NB * (SEQ_ / 64) * 4;
    v4u pa = {0u, 0u, 0u, 0u};
#define TR_LOAD(tile_) do { const int c0_ = ((tile_) % 4) * 64, t0_ = (((tile_) / 4) % (SEQ_ / 64)) * 64, b_ = (tile_) / (4 * (SEQ_ / 64)); pa = *(const v4u*)(yt + ((size_t)b_ * 256 + c0_ + (tix >> 3)) * SEQ_ + t0_ + 8 * (tix & 7)); } while (0)
    if ((int)blockIdx.x < NT) TR_LOAD((int)blockIdx.x);
    for (int tile = blockIdx.x; tile < NT; tile += gridDim.x) {
        const int c0 = (tile % 4) * 64, t0 = ((tile / 4) % (SEQ_ / 64)) * 64, b = tile / (4 * (SEQ_ / 64));
        *(LAS v4u*)(TL + (tix >> 3) * 72 + 8 * (tix & 7)) = pa;
        LDS_BARRIER();
        if (tile + (int)gridDim.x < NT) TR_LOAD(tile + (int)gridDim.x);
        { const int t = tix >> 3, j = tix & 7; unsigned short x[8];
#pragma unroll
          for (int i = 0; i < 8; ++i) x[i] = TL[(8 * j + i) * 72 + t];
          *(v4u*)(mixin + ((size_t)b * SEQ_ + t0 + t) * (size_t)ms + 768 + c0 + 8 * j) = (v4u){(unsigned)x[0] | ((unsigned)x[1] << 16), (unsigned)x[2] | ((unsigned)x[3] << 16), (unsigned)x[4] | ((unsigned)x[5] << 16), (unsigned)x[6] | ((unsigned)x[7] << 16)}; }
        LDS_BARRIER();
    }
#undef TR_LOAD
}
__device__ __forceinline__ void ew_hy_filter(LAS unsigned char* lds, const float* w1a, const float* b1a, const float* fqa, const float* w2a, const float* b2a, const float* w3a, pt* RF2, int wv_) {
    const int tix = opaque_tid(), lane = tix & 63, wave = tix >> 6; LAS unsigned short* TL = (LAS unsigned short*)lds;
    for (int i = blockIdx.x * 512 + tix; i < 1024 * 385; i += gridDim.x * 512) { const int rw = i / 385, j = i % 385; const int idx = j < 129 ? j : (2 * SEQ_ - 1) + j; RF2[(size_t)rw * RFL + idx] = 0; }
    for (int tile = blockIdx.x; tile < 2 * (SEQ_ / 64); tile += gridDim.x) {
        const int l = tile / (SEQ_ / 64), n0 = (tile % (SEQ_ / 64)) * 64;
        const float* w1 = w1a + l * 33 * 64; const float* b1 = b1a + l * 64; const float* fq = fqa + l * 64; const float* w2 = w2a + l * 2 * 4096; const float* b2 = b2a + l * 128; const float* w3 = w3a + (size_t)l * 64 * 1024;
        const float fr = fq[lane];
        float h3[8];
#pragma unroll
        for (int i = 0; i < 8; ++i) { const int n = n0 + 8 * wave + i;
            const float zf = lane < 33 ? hy_feat(n, lane) : 0.f;
            float a = b1[lane];
            for (int k = 0; k < 33; ++k) a += __shfl(zf, k) * w1[k * 64 + lane];
            float hh = sinf(fr * a);
            a = b2[lane];
            for (int k = 0; k < 64; ++k) a += __shfl(hh, k) * w2[k * 64 + lane];
            hh = sinf(fr * a);
            a = b2[64 + lane];
            for (int k = 0; k < 64; ++k) a += __shfl(hh, k) * w2[4096 + k * 64 + lane];
            h3[i] = sinf(fr * a); }
#pragma unroll 1
        for (int mh = 0; mh < 4; ++mh) {
            float acc[4][8];
#pragma unroll
            for (int m = 0; m < 4; ++m)
#pragma unroll
                for (int i = 0; i < 8; ++i) acc[m][i] = 0.f;
            for (int k = 0; k < 64; ++k) { float wv[4];
#pragma unroll
                for (int m = 0; m < 4; ++m) wv[m] = w3[(size_t)k * 1024 + mh * 256 + m * 64 + lane];
#pragma unroll
                for (int i = 0; i < 8; ++i) { const float hv = __shfl(h3[i], k);
#pragma unroll
                    for (int m = 0; m < 4; ++m) acc[m][i] += hv * wv[m]; } }
#pragma unroll
            for (int m = 0; m < 4; ++m) { const int c = m * 64 + lane; const float mind = -3.0701134573253944f, maxd = -15.350567286626972f; const float ad = fabsf(mind + (float)c * ((maxd - mind) / 255.0f));
#pragma unroll
                for (int i = 0; i < 8; ++i) { const int n = n0 + 8 * wave + i; const float tn = (float)n / (float)(SEQ_ - 1); TL[(mh * 256 + c) * 66 + 8 * wave + i] = (unsigned short)f2bf(acc[m][i] * expf(-tn * ad)); } }
        }
        __syncthreads();
        for (int i = tix; i < 1024 * 64; i += 512) { const int col = i >> 6, p = i & 63, od = col >> 8, c = col & 255, o = od >> 1, d = od & 1, n = n0 + p;
            if (d == 0 || n >= 1) { const int y = d == 0 ? SEQ_ - 1 - n : SEQ_ - 1 + n; RF2[((size_t)l * 512 + o * 256 + c) * RFL + 129 + y] = TL[col * 66 + p]; } }
        __syncthreads();
    }
}
__device__ __forceinline__ void split8(const f32x4& x0, const f32x4& x1, sbf16x8& hi, sbf16x8& lo) {
    v4u h, l;
    h.x = cvtpk(x0[0], x0[1]); l.x = cvtpk(x0[0] - bfl(h.x), x0[1] - bfh(h.x)); h.y = cvtpk(x0[2], x0[3]); l.y = cvtpk(x0[2] - bfl(h.y), x0[3] - bfh(h.y));
    h.z = cvtpk(x1[0], x1[1]); l.z = cvtpk(x1[0] - bfl(h.z), x1[1] - bfh(h.z)); h.w = cvtpk(x1[2], x1[3]); l.w = cvtpk(x1[2] - bfl(h.w), x1[3] - bfh(h.w));
    hi = __builtin_bit_cast(sbf16x8, h); lo = __builtin_bit_cast(sbf16x8, l);
}
__device__ __forceinline__ void ew_hy_filter2(LAS unsigned char* lds, const float* w1a, const float* b1a, const float* fqa, const float* w2a, const float* b2a, const float* w3a, pt* RF2,
                                              const float* x, const float* lng, const float* lnb, pt* HBo, int wv_) {
    const int tix = opaque_tid(), lane = tix & 63, wave = tix >> 6, r = lane & 15, g4 = lane >> 4;
    const int gw = wave * gridDim.x + blockIdx.x, NGW = gridDim.x * 8; int lrow = gw; f32x4 nx[2][4];
    LAS float* GBL = (LAS float*)(lds + 1024 * 66 * 2 + 64 * 68 * 4);
    for (int i = tix; i < 2048; i += 512) GBL[i] = i < 1024 ? lng[i] : lnb[i - 1024];
    __syncthreads();
#pragma unroll
    for (int u = 0; u < 2; ++u) if (gw + u * NGW < T) {
#pragma unroll
        for (int j = 0; j < 4; ++j) nx[u][j] = *(const f32x4*)(x + (size_t)(gw + u * NGW) * DM + 256 * j + 4 * lane); }
#define LN_STEP2() do { _Pragma("unroll") for (int u = 0; u < 2; ++u) { const int row = lrow + u * NGW; if (row < T) { f32x4 v[4]; \
            _Pragma("unroll") for (int j = 0; j < 4; ++j) v[j] = nx[u][j]; \
            if (row + 2 * NGW < T) { _Pragma("unroll") for (int j = 0; j < 4; ++j) nx[u][j] = *(const f32x4*)(x + (size_t)(row + 2 * NGW) * DM + 256 * j + 4 * lane); } \
            ln_finish_l(v, GBL, nullptr, HBo + (size_t)row * DM, lane); } } lrow += 2 * NGW; } while (0)
    LAS unsigned short* TL = (LAS unsigned short*)lds;
    LAS float* H3 = (LAS float*)(lds + 1024 * 66 * 2);
    for (int i = blockIdx.x * 512 + tix; i < 1024 * 385; i += gridDim.x * 512) { const int rw = i / 385, j = i % 385; const int idx = j < 129 ? j : (2 * SEQ_ - 1) + j; RF2[(size_t)rw * RFL + idx] = 0; }
    for (int tile = blockIdx.x; tile < 2 * (SEQ_ / 64); tile += gridDim.x) {
        const int l = tile / (SEQ_ / 64), n0 = (tile % (SEQ_ / 64)) * 64;
        const float* w3 = w3a + (size_t)l * 64 * 1024;
        { const float* w1 = w1a + l * 33 * 64; const float* w2 = w2a + l * 2 * 4096;
          const float fr = fqa[l * 64 + lane];
          { const float bb1 = b1a[l * 64 + lane]; float wr[33];
#pragma unroll
            for (int k = 0; k < 33; ++k) wr[k] = w1[k * 64 + lane];
#pragma unroll 1
            for (int i = 0; i < 8; ++i) { const int n = n0 + 8 * wave + i;
                const float zf = lane < 33 ? hy_feat(n, lane) : 0.f;
                float a0 = bb1, a1 = 0.f;
#pragma unroll
                for (int k = 0; k < 33; ++k) { if (k & 1) a1 += rdlane(zf, k) * wr[k]; else a0 += rdlane(zf, k) * wr[k]; }
                H3[(8 * wave + i) * 68 + lane] = __sinf(fr * (a0 + a1));
                if ((i & 3) == 3) LN_STEP2(); } }
#pragma unroll 1
          for (int j = 0; j < 2; ++j) { const float bb = b2a[l * 128 + j * 64 + lane]; float wr[64];
#pragma unroll
            for (int k = 0; k < 64; ++k) wr[k] = w2[j * 4096 + k * 64 + lane];
#pragma unroll 1
            for (int i = 0; i < 8; ++i) { const float hh = H3[(8 * wave + i) * 68 + lane];
                float a0 = bb, a1 = 0.f;
#pragma unroll
                for (int k = 0; k < 64; ++k) { if (k & 1) a1 += rdlane(hh, k) * wr[k]; else a0 += rdlane(hh, k) * wr[k]; }
                H3[(8 * wave + i) * 68 + lane] = __sinf(fr * (a0 + a1));
                if ((i & 3) == 3) LN_STEP2(); } } }
        __syncthreads();
        { sbf16x8 Ah[4][2], Al[4][2];
#pragma unroll
          for (int mt = 0; mt < 4; ++mt)
#pragma unroll
              for (int ks = 0; ks < 2; ++ks) { const LAS float* hp = H3 + (16 * mt + r) * 68 + 32 * ks + 8 * g4; const f32x4 x0 = *(const LAS f32x4*)hp, x1 = *(const LAS f32x4*)(hp + 4); split8(x0, x1, Ah[mt][ks], Al[mt][ks]); }
#pragma unroll
          for (int nt = 0; nt < 8; ++nt) {
              const int col = 128 * wave + 16 * nt + r; sbf16x8 Bh[2], Bl[2];
#pragma unroll
              for (int ks = 0; ks < 2; ++ks) { f32x4 x0, x1;
#pragma unroll
                  for (int j = 0; j < 4; ++j) { x0[j] = w3[(size_t)(32 * ks + 8 * g4 + j) * 1024 + col]; x1[j] = w3[(size_t)(32 * ks + 8 * g4 + 4 + j) * 1024 + col]; }
                  split8(x0, x1, Bh[ks], Bl[ks]); }
              const int c = col & 255; const float mind = -3.0701134573253944f, maxd = -15.350567286626972f; const float ad = fabsf(mind + (float)c * ((maxd - mind) / 255.0f));
#pragma unroll
              for (int mt = 0; mt < 4; ++mt) { f32x4 acc = {0.f, 0.f, 0.f, 0.f};
#pragma unroll
                  for (int ks = 0; ks < 2; ++ks) { acc = __builtin_amdgcn_mfma_f32_16x16x32_bf16(Al[mt][ks], Bh[ks], acc, 0, 0, 0); acc = __builtin_amdgcn_mfma_f32_16x16x32_bf16(Ah[mt][ks], Bl[ks], acc, 0, 0, 0);
                      acc = __builtin_amdgcn_mfma_f32_16x16x32_bf16(Ah[mt][ks], Bh[ks], acc, 0, 0, 0); }
                  float v[4];
#pragma unroll
                  for (int i = 0; i < 4; ++i) { const int n = n0 + 16 * mt + 4 * g4 + i; const float tn = (float)n / (float)(SEQ_ - 1); v[i] = acc[i] * __expf(-tn * ad); }
                  LAS unsigned* tp = (LAS unsigned*)(TL + col * 66 + 16 * mt + 4 * g4); tp[0] = cvtpk(v[0], v[1]); tp[1] = cvtpk(v[2], v[3]); }
              if ((nt & 3) == 3) LN_STEP2(); } }
        __syncthreads();
        for (int i = tix; i < 1024 * 64; i += 512) { const int col = i >> 6, p = i & 63, od = col >> 8, c = col & 255, o = od >> 1, d = od & 1, n = n0 + p;
            if (d == 0 || n >= 1) { const int y = d == 0 ? SEQ_ - 1 - n : SEQ_ - 1 + n; RF2[((size_t)l * 512 + o * 256 + c) * RFL + 129 + y] = TL[col * 66 + p]; } }
        __syncthreads();
    }
    while (lrow < T) LN_STEP2();
#undef LN_STEP2
}
__device__ __forceinline__ void ew_hy_norm(const pt* RF2, float* INVN2, int wv_) {
    const int tix = opaque_tid(), lane = tix & 63; const int gw = (tix >> 6) * gridDim.x + blockIdx.x, NGW = gridDim.x * 8;
    for (int rw = gw; rw < 1024; rw += NGW) { const v4u* p = (const v4u*)(RF2 + (size_t)rw * RFL); float s = 0.f;
        constexpr int NV = (RFL / 8 + 63) / 64; v4u vv[NV];
#pragma unroll
        for (int i = 0; i < NV; ++i) { const int ix = lane + 64 * i; vv[i] = ix < RFL / 8 ? p[ix] : (v4u){0u, 0u, 0u, 0u}; }
#pragma unroll
        for (int i = 0; i < NV; ++i)
#pragma unroll
            for (int e = 0; e < 4; ++e) s += fabsf(bfl(vv[i][e])) + fabsf(bfh(vv[i][e]));
        s = wsum(s); if (lane == 0) INVN2[rw] = 1.0f / fmaxf(s, 1e-12f); }
}

__device__ __forceinline__ void transpose_item(const float* src, int ld_src, pt* dst, int ld_dst, LAS float* scr, int lane) {
#pragma unroll 8
    for (int i = 0; i < 32; ++i) { const int kk = 2 * i + (lane >> 5); scr[kk * 33 + (lane & 31)] = src[(size_t)kk * ld_src + (lane & 31)]; }
    asm volatile("s_waitcnt lgkmcnt(0)" ::: "memory");
    const int c = lane & 7;
#pragma unroll
    for (int j = 0; j < 4; ++j) { const int n = (lane >> 3) + 8 * j; const LAS float* s = scr + (8 * c) * 33 + n;
        v4u o; o.x = f2bf(s[0]) | (f2bf(s[33]) << 16); o.y = f2bf(s[66]) | (f2bf(s[99]) << 16); o.z = f2bf(s[132]) | (f2bf(s[165]) << 16); o.w = f2bf(s[198]) | (f2bf(s[231]) << 16);
        *(v4u*)(dst + (size_t)n * ld_dst + 8 * c) = o; }
    asm volatile("s_waitcnt lgkmcnt(0)" ::: "memory");
}
__device__ __forceinline__ void convert_weights(const MP& p, int l, LAS unsigned char* lds, int which  , int wv_, int vb = -1, int vn = 0) {
    const int tix = opaque_tid(); const int lane = tix & 63, wave = tix >> 6;
    LAS float* scr = (LAS float*)(lds + wave * 16384);
    if (vb < 0) { vb = blockIdx.x; vn = gridDim.x; }
    const int gw = wave * vn + vb, NGW = vn * 8;
    char* ws = p.ws;
    pt* WinT = (pt*)(ws + OFF_WIN); pt* WoT = (pt*)(ws + OFF_WO); pt* WguT = (pt*)(ws + OFF_WGU); pt* WdT = (pt*)(ws + OFF_WD);
    const float* w_in = p.in[3] + (size_t)l * DM * DIN; const float* w_out = p.in[18] + (size_t)l * DM * DM;
    const float* wg = p.in[25] + (size_t)l * 16 * DM * 512; const float* wu = p.in[26] + (size_t)l * 16 * DM * 512; const float* wd = p.in[27] + (size_t)l * 16 * 512 * DM;
    constexpr int I_IN = 16 * (DIN / 32), I_O = 16 * 32, I_GU = 16 * 2 * 16 * 16, I_D = 16 * 8 * 32, NIT = I_IN + I_O + I_GU + I_D;
    for (int it = gw; it < NIT; it += NGW) {
        int r = it;
        if (r < I_IN ? !(which & 1) : (r < I_IN + I_O ? !(which & 2) : !(which & 4))) continue;
        if (r < I_IN) { const int kb = r / (DIN / 32), nb = r % (DIN / 32); transpose_item(w_in + (size_t)kb * 64 * DIN + oldcol(nb * 32), DIN, WinT + (size_t)nb * 32 * DM + kb * 64, DM, scr, lane); continue; } r -= I_IN;
        if (r < I_O) { const int kb = r / 32, nb = r % 32; transpose_item(w_out + (size_t)kb * 64 * DM + nb * 32, DM, WoT + (size_t)nb * 32 * DM + kb * 64, DM, scr, lane); continue; } r -= I_O;
        if (r < I_GU) { const int e = r / 512, hf = (r / 256) & 1, kb = (r / 16) & 15, nb = r & 15; const float* s = (hf ? wu : wg) + (size_t)e * DM * 512 + (size_t)kb * 64 * 512 + nb * 32;
            transpose_item(s, 512, WguT + (size_t)e * 1024 * 1024 + (size_t)((nb >> 2) * 256 + hf * 128 + (nb & 3) * 32) * 1024 + kb * 64, 1024, scr, lane); continue; } r -= I_GU;
        { const int e = r / 256, kb = (r / 32) & 7, nb = r & 31; transpose_item(wd + (size_t)e * 512 * DM + (size_t)kb * 64 * DM + nb * 32, DM, WdT + (size_t)e * 1024 * 512 + (size_t)nb * 32 * 512 + kb * 64, 512, scr, lane); }
    }
    if (which & 1) { v4u z = {0u, 0u, 0u, 0u}; v4u* zp = (v4u*)(WinT + (size_t)DIN * DM); const size_t nz = (size_t)(NP - DIN) * DM * 2 / 16;
      for (size_t i = (size_t)vb * 512 + tix; i < nz; i += (size_t)vn * 512) zp[i] = z; }
}
#endif

#define GS_LOOP(N) for (size_t id = gtid; id < (size_t)(N); id += gstride)
template <int S> __device__ __forceinline__ void run_stage(const MP& p, int l, void* ldsv, int wv_) {
#ifdef CPU_EMU
    const unsigned tix = threadIdx.x;
#else
    const unsigned tix = (unsigned)opaque_tid();
#endif
    const size_t gtid = ((size_t)(tix >> 6) * gridDim.x + blockIdx.x) * 64 + (tix & 63);
    const size_t gstride = (size_t)gridDim.x * blockDim.x;
    const float *x = p.in[0], *ln_in_g = p.in[1], *ln_in_b = p.in[2], *w_in = p.in[3], *gla_wa2 = p.in[4], *gla_ba = p.in[5], *gla_norm_g = p.in[6], *hg_lb_logits = p.in[7],
                *hg_norm_g = p.in[8], *hy_conv_w = p.in[9], *hy_conv_b = p.in[10], *hy_w1 = p.in[11], *hy_b1 = p.in[12], *hy_freq = p.in[13], *hy_w2 = p.in[14], *hy_b2 = p.in[15],
                *hy_w3 = p.in[16], *hy_bias = p.in[17], *w_out = p.in[18], *ln1_g = p.in[19], *ln1_b = p.in[20], *moe_wr_g = p.in[21], *moe_br_g = p.in[22], *moe_wr_e = p.in[23],
                *moe_br_e = p.in[24], *moe_w_gate = p.in[25], *moe_w_up = p.in[26], *moe_w_down = p.in[27], *ln2_g = p.in[28], *ln2_b = p.in[29];
    float* H = p.out; char* ws = p.ws;
    pt* PROJ = (pt*)(ws + OFF_PROJ); pt* XB = (pt*)(ws + OFF_XB); pt* MIXIN = XB; pt* U2 = (pt*)(ws + OFF_U2); pt* Z1 = (pt*)(ws + OFF_Z1); pt* AL = (pt*)(ws + OFF_AL);
    float* HF = (float*)(ws + OFF_HF); float* HA = (float*)(ws + OFF_HA); float* HB = (float*)(ws + OFF_HB); float* INVN = (float*)(ws + OFF_INVN); float* LB = (float*)(ws + OFF_LB);
    int* RE = (int*)(ws + OFF_RE); float* RW = (float*)(ws + OFF_RW); float* MIX = (float*)(ws + OFF_MIX); pt* HID = (pt*)(ws + OFF_HID); pt* Y = (pt*)(ws + OFF_Y); pt* XS = (pt*)(ws + OFF_XS);
#if OPT_EW && !defined(CPU_EMU)
#define EWG 1
    pt* RFs = (pt*)(ws + OFF_RF) + (size_t)l * 512 * RFL; INVN += l * 512;
#else
#define EWG 0
    pt* RFs = (pt*)(ws + OFF_RF);
#endif
    pt* YT = (pt*)(ws + OFF_YT);
    int* SLOT = (int*)(ws + OFF_SLOT); int* CNT = (int*)(ws + OFF_CNT); int* CUR = CNT + 16;
    (void)w_in; (void)w_out; (void)ldsv;
    if constexpr (S < 0) {
        GS_LOOP(768) d_k_lb(hg_lb_logits, LB, id);
#if EWG
        ew_ln_in(x, ln_in_g, ln_in_b, H, XB, wv_);
        ew_hy_filter((LAS unsigned char*)ldsv, hy_w1, hy_b1, hy_freq, hy_w2, hy_b2, hy_w3, (pt*)(ws + OFF_RF), wv_);
#else
        GS_LOOP(T) d_k_ln(x, nullptr, 1.0f, ln_in_g, ln_in_b, H, XB, id);
#endif
    }
    if constexpr (S == 0) {
#if OPT_GEMM && !defined(CPU_EMU)
        convert_weights(p, l, (LAS unsigned char*)ldsv, 7, wv_);
#endif
#if EWG
        if (l == 0) ew_hy_norm((const pt*)(ws + OFF_RF), (float*)(ws + OFF_INVN), wv_);
#else
        GS_LOOP(L * 64) d_k_hy_mlp1(hy_w1 + l * 33 * 64, hy_b1 + l * 64, hy_freq + l * 64, HA, id);
#endif
        if (gtid < 32) CNT[gtid] = 0;
    }
    if constexpr (S == 1) {
#if OPT_GEMM && !defined(CPU_EMU)
        { SchedStatic Sc; Sc.init(XB, ws + OFF_WIN, T, NP, DM, gridDim.x, blockIdx.x); pg8::Gemm g{(const pg8::bf16_t*)XB, (const pg8::bf16_t*)(ws + OFF_WIN), T, NP, DM, DM};
          EpiBf16Store E{PROJ, NP}; pg8::gemm_phase<EpiBf16Store, SchedStatic, true, true>((LAS unsigned char*)ldsv, g, Sc, E, wv_); }
#else
        GS_LOOP((size_t)(T / 4) * DIN) d_k_inproj(H, w_in + (size_t)l * DM * DIN, PROJ, id);
#endif
#if !EWG
        GS_LOOP(L * 64) d_k_hy_mlp2(HA, hy_w2 + (l * 2 + 0) * 4096, hy_b2 + (l * 2 + 0) * 64, hy_freq + l * 64, HB, id);
#endif
    }
    if constexpr (S == 2) {
        GS_LOOP(L * 64) d_k_hy_mlp2(HB, hy_w2 + (l * 2 + 1) * 4096, hy_b2 + (l * 2 + 1) * 64, hy_freq + l * 64, HA, id);
#if !(OPT_SCAN && !defined(CPU_EMU))
        GS_LOOP((size_t)2 * T * 192) d_k_gla_alogit(PROJ, gla_wa2 + l * 2 * 16 * 192, gla_ba + l * 2 * 192, AL, id);
#endif
    }
#if OPT_SCAN && !defined(CPU_EMU)
    const ScanP spg{PROJ, gla_wa2 + l * 2 * 16 * 192, gla_ba + l * 2 * 192, LB + l * 768, (pt*)(ws + OFF_DSG), (float*)(ws + OFF_DDG), MIXIN, gla_norm_g + l * 384, (pt*)(ws + OFF_AL), DM};
    const ScanP sph{PROJ, gla_wa2, gla_ba, LB + l * 768, (pt*)(ws + OFF_DSH), (float*)(ws + OFF_DDH), MIXIN, hg_norm_g + l * 384, (pt*)(ws + OFF_AL), DM};
#endif
    if constexpr (S == 3) {
#if OPT_SCAN && !defined(CPU_EMU)
        scan_p1<1>((LAS unsigned char*)ldsv, sph, wv_); scan_p1<0>((LAS unsigned char*)ldsv, spg, wv_);
#endif
#if !EWG
        GS_LOOP(L * 1024) d_k_hy_filt(HA, hy_w3 + (size_t)l * 64 * 1024, HF, id);
#endif
    }
    if constexpr (S == 4) {
#if OPT_SCAN && !defined(CPU_EMU)
        GS_LOOP((size_t)NB * 12 * 1536) scan_p2(spg.DS, spg.DD, sph.DS, sph.DD, id);
#endif
#if !EWG
        GS_LOOP(512) d_k_hy_norm(HF, INVN, id);
        GS_LOOP((size_t)512 * RFL) d_k_hy_rf(HF, RFs, id);
#endif
    }
    if constexpr (S == 5) {
#if OPT_SCAN && !defined(CPU_EMU)
        scan_p3<1>((LAS unsigned char*)ldsv, sph, wv_); scan_p3<0>((LAS unsigned char*)ldsv, spg, wv_);
#else
        GS_LOOP(NB * 6 * 64) d_k_scan_hg(PROJ, LB + l * 768, MIXIN, id);
        GS_LOOP(NB * 6 * 64) d_k_scan_gla(PROJ, AL, MIXIN, id);
#endif
    }
    if constexpr (S == 6) {
#if EWG
        ew_hy_prep((LAS unsigned char*)ldsv, PROJ, hy_conv_w + l * 3 * 768, hy_conv_b + l * 768, U2, wv_);
#else
        GS_LOOP((size_t)T * 768) d_k_hy_prep(PROJ, hy_conv_w + l * 3 * 768, hy_conv_b + l * 768, U2, id);
#endif
#if !(OPT_SCAN && !defined(CPU_EMU))
        GS_LOOP(T * 12) d_k_headnorm(PROJ, gla_norm_g + l * 384, hg_norm_g + l * 384, MIXIN, id);
#endif
    }
    if constexpr (S == 7) {
#if OPT_HY && !defined(CPU_EMU)
        hy_conv_mfma((LAS unsigned char*)ldsv, U2, 768, U2 + (size_t)256 * L, 768, RFs, INVN, hy_bias + (l * 2 + 0) * 256, Z1, 256, wv_);
#else
        GS_LOOP((size_t)T * 256) d_k_hy_conv_cm(U2, 768, U2 + (size_t)256 * L, 768, RFs, INVN, hy_bias + (l * 2 + 0) * 256, Z1, 256, id);
#endif
    }
    if constexpr (S == 8) {
#if OPT_HY && !defined(CPU_EMU)
        hy_conv_mfma((LAS unsigned char*)ldsv, Z1, 256, U2 + (size_t)512 * L, 768, RFs + (size_t)256 * RFL, INVN + 256, hy_bias + (l * 2 + 1) * 256, YT, 256, wv_);
#else
        GS_LOOP((size_t)T * 256) d_k_hy_conv_cm(Z1, 256, U2 + (size_t)512 * L, 768, RFs + (size_t)256 * RFL, INVN + 256, hy_bias + (l * 2 + 1) * 256, YT, 256, id);
#endif
    }
    if constexpr (S == 9) {
#if EWG
        ew_hy_tr((LAS unsigned char*)ldsv, YT, MIXIN, DM, wv_);
#else
        GS_LOOP((size_t)T * 256) d_k_hy_tr(YT, MIXIN, id);
#endif
    }
    if constexpr (S == 10) {
#if OPT_GEMM && !defined(CPU_EMU)
        { SchedStatic Sc; Sc.init(MIXIN, ws + OFF_WO, T, DM, DM, gridDim.x, blockIdx.x); pg8::Gemm g{(const pg8::bf16_t*)MIXIN, (const pg8::bf16_t*)(ws + OFF_WO), T, DM, DM, DM};
          EpiF32Store E{MIX, DM}; pg8::gemm_phase<EpiF32Store, SchedStatic, true, true>((LAS unsigned char*)ldsv, g, Sc, E, wv_); }
#else
        GS_LOOP((size_t)(T / 4) * DM) d_k_outproj(MIXIN, w_out + (size_t)l * DM * DM, MIX, id);
#endif
    }
    if constexpr (S == 11) {
#if EWG
        ew_ln1_route<false>((LAS unsigned char*)ldsv, H, H, MIX, ln1_g + l * DM, ln1_b + l * DM, XB, moe_wr_g + l * DM * 4, moe_br_g + l * 4, moe_wr_e + l * DM * 16, moe_br_e + l * 16, RE, RW, CNT, wv_);
#else
        GS_LOOP(T) d_k_ln(H, MIX, ALPHA, ln1_g + l * DM, ln1_b + l * DM, H, XB, id);
#endif
    }
    if constexpr (S == 12) {
        GS_LOOP(T) d_k_route(H, moe_wr_g + l * DM * 4, moe_br_g + l * 4, moe_wr_e + l * DM * 16, moe_br_e + l * 16, RE, RW, CNT, id);
    }
    if constexpr (S == 13) {
        GS_LOOP(T) d_k_moe_assign(RE, CNT, CUR, SLOT, id);
    }
    if constexpr (S == 14) {
#if EWG
        ew_assign_gather((LAS unsigned char*)ldsv, RE, CNT, CUR, SLOT, XB, XS, wv_);
#else
        GS_LOOP((size_t)T * 2 * DM) d_k_moe_gather(XB, SLOT, XS, id);
#endif
    }
    if constexpr (S == 15) {
#if OPT_MOE && !defined(CPU_EMU)
        { SchedMoE Sc; Sc.init(XS, ws + OFF_WGU, DM, CNT, (size_t)1024 * 1024 * 2, gridDim.x, blockIdx.x); pg8::Gemm g{(const pg8::bf16_t*)XS, (const pg8::bf16_t*)(ws + OFF_WGU), NSLOT, 1024, DM, DM};
          EpiSiluMul E{HID}; pg8::gemm_phase<EpiSiluMul, SchedMoE, true, true>((LAS unsigned char*)ldsv, g, Sc, E, wv_); }
#else
        GS_LOOP((size_t)NSLOT * 512) d_k_moe_hid2(XS, CNT, moe_w_gate + (size_t)l * 16 * DM * 512, moe_w_up + (size_t)l * 16 * DM * 512, HID, id);
#endif
    }
    if constexpr (S == 16) {
#if OPT_MOE && !defined(CPU_EMU)
        { SchedMoE Sc; Sc.init(HID, ws + OFF_WD, 512, CNT, (size_t)1024 * 512 * 2, gridDim.x, blockIdx.x); pg8::Gemm g{(const pg8::bf16_t*)HID, (const pg8::bf16_t*)(ws + OFF_WD), NSLOT, 1024, 512, 512};
          EpiBf16Store E{Y, DM}; pg8::gemm_phase<EpiBf16Store, SchedMoE, true, true>((LAS unsigned char*)ldsv, g, Sc, E, wv_); }
#else
        GS_LOOP((size_t)NSLOT * DM) d_k_moe_down2(HID, CNT, moe_w_down + (size_t)l * 16 * 512 * DM, Y, id);
#endif
    }
    if constexpr (S == 17) {
#if EWG
        ew_ln2(H, H, Y, SLOT, RW, ln2_g + l * DM, ln2_b + l * DM, XB, wv_);
#else
        GS_LOOP(T) d_k_ln2(H, Y, SLOT, RW, ALPHA, ln2_g + l * DM, ln2_b + l * DM, H, XB, id);
#endif
    }
}


#ifndef CPU_EMU
constexpr size_t G_INVN = al256c(OFF_WEND), G_LB = al256c(G_INVN + 1024 * 4), G_RE = al256c(G_LB + 2 * 768 * 4), G_RW = al256c(G_RE + (size_t)T * 8), G_SLOT = al256c(G_RW + (size_t)T * 8), G_CNT = al256c(G_SLOT + (size_t)T * 8),
                 G_TOKR = al256c(G_CNT + 256), G_BAR = al256c(G_TOKR + (size_t)NSLOT * 4), G_DDG = al256c(G_BAR + 3456 * 4), G_DDH = al256c(G_DDG + (size_t)NB * 12 * (L / 64) * 32 * 4), G_PROJ = al256c(G_DDH + (size_t)NB * 12 * (L / 64) * 64 * 4),
                 G_XB = al256c(G_PROJ + (size_t)T * NPS * 2), G_DSH = al256c(G_XB + (size_t)T * DM * 2), G_DSG = al256c(G_DSH + (size_t)NB * 12 * (L / 64) * 64 * 64 * 2), G_AL = al256c(G_DSG + (size_t)NB * 12 * (L / 64) * 64 * 32 * 2),
                 G_RF = al256c(G_AL + (size_t)2 * T * 192 * 2), G_END = al256c(G_RF + (size_t)1024 * RFL * 2);
constexpr size_t G_Z1 = OFF_WGU, G_YT = OFF_WGU + (size_t)T * 256 * 2, G_U2 = G_XB, G_MIXB = G_XB, G_XS = G_PROJ, G_Y = G_PROJ, G_HID = al256c(G_XS + (size_t)NSLOT * DM * 2);
static_assert(G_END <= 512 * MiB && G_HID + (size_t)NSLOT * 512 * 2 <= G_XB && (size_t)T * 512 * 2 <= (size_t)16 * 1024 * 1024 * 2 && (size_t)T * 768 * 2 <= (size_t)T * DM * 2, "fused workspace map");
constexpr int NGS = 11;
template <int S> __device__ __forceinline__ void gstage(const MP& p, int l, void* ldsv, int wv_) {
    const unsigned tix = (unsigned)make_tid(wv_);
    int bid = blockIdx.x; asm volatile("" : "+s"(bid));
    const size_t gtid = ((size_t)(tix >> 6) * gridDim.x + blockIdx.x) * 64 + (tix & 63);
    const size_t gstride = (size_t)gridDim.x * 512;
    char* ws = p.ws; LAS unsigned char* lds = (LAS unsigned char*)ldsv;
    pt* HB = (pt*)p.out;
    pt* HB1 = (l + 1 < DEPTH) ? HB : (pt*)(ws + G_XB);
    pt* PROJ = (pt*)(ws + G_PROJ); pt* XB = (pt*)(ws + G_XB); pt* U2 = (pt*)(ws + G_U2); pt* Z1 = (pt*)((char*)p.out + (size_t)T * DM * 2); pt* YT = Z1 + (size_t)T * 256; pt* MIXB = (pt*)(ws + G_MIXB);
    pt* RFs = (pt*)(ws + G_RF) + (size_t)l * 512 * RFL; float* INVN = (float*)(ws + G_INVN) + l * 512; float* LB = (float*)(ws + G_LB);
    int* RE = (int*)(ws + G_RE); float* RW = (float*)(ws + G_RW); int* SLOT = (int*)(ws + G_SLOT); int* CNT = (int*)(ws + G_CNT); int* CUR = CNT + 16; int* TOKR = (int*)(ws + G_TOKR);
    pt* XS = (pt*)(ws + G_XS); pt* HID = (pt*)(ws + G_HID); pt* Y = (pt*)(ws + G_Y);
    const ScanP spg{PROJ, p.in[4] + l * 2 * 16 * 192, p.in[5] + l * 2 * 192, LB + l * 768, (pt*)(ws + G_DSG), (float*)(ws + G_DDG), PROJ, p.in[6] + l * 384, (pt*)(ws + G_AL), NPS};
    const ScanP sph{PROJ, p.in[4], p.in[5], LB + l * 768, (pt*)(ws + G_DSH), (float*)(ws + G_DDH), PROJ, p.in[8] + l * 384, (pt*)(ws + G_AL), NPS};
    if constexpr (S < 0) {
        GS_LOOP(768) d_k_lb(p.in[7], LB, id);
        if (gtid < 32) CNT[gtid] = 0;
        convert_weights(p, 0, lds, 1, wv_);
        __syncthreads();
        ew_hy_filter2(lds, p.in[11], p.in[12], p.in[13], p.in[14], p.in[15], p.in[16], (pt*)(ws + G_RF), p.in[0], p.in[1], p.in[2], HB, wv_);
    }
    if constexpr (S == 0) {
        SchedStatic Sc; Sc.init(HB, ws + OFF_WIN, T, NP, DM, gridDim.x, bid); pg8::Gemm g{(const pg8::bf16_t*)HB, (const pg8::bf16_t*)(ws + OFF_WIN), T, NP, DM, DM};
        EpiProjAct E{PROJ, NPS, LB + l * 768}; pg8::gemm_phase<EpiProjAct, SchedStatic, true, true>(lds, g, Sc, E, wv_);
        if (l == 0) ew_hy_norm((const pt*)(ws + G_RF), (float*)(ws + G_INVN), wv_);
    }
    if constexpr (S == 1) {
        scan_p1<1>(lds, sph, wv_); scan_p1<0>(lds, spg, wv_);
        ew_hy_prep(lds, PROJ, p.in[9] + l * 3 * 768, p.in[10] + l * 768, U2, wv_);
    }
    if constexpr (S == 2) {
        const int nwv = (int)gridDim.x * 8;
        if ((P2_NT + nwv - 1) / nwv <= 64) {
            const P2Side ps = p2_side_init(spg.DS, spg.DD, sph.DS, sph.DD, wv_ * (int)gridDim.x + bid, nwv, (int)(tix & 63));
            hy_conv_mfma<2>(lds, U2, 768, U2 + (size_t)256 * L, 768, RFs, INVN, p.in[17] + (l * 2 + 0) * 256, Z1, 256, wv_, MoeCvt(), ps);
        } else { GS_LOOP((size_t)NB * 12 * 1536) scan_p2(spg.DS, spg.DD, sph.DS, sph.DD, id);
            hy_conv_mfma(lds, U2, 768, U2 + (size_t)256 * L, 768, RFs, INVN, p.in[17] + (l * 2 + 0) * 256, Z1, 256, wv_); }
    }
    if constexpr (S == 3) {
        scan_p3<1>(lds, sph, wv_); scan_p3<0>(lds, spg, wv_);
        MoeCvt mc{p.in[25] + (size_t)l * 16 * DM * 512, (long)((const char*)p.in[26] - (const char*)p.in[25]), p.in[27] + (size_t)l * 16 * 512 * DM, (pt*)(ws + OFF_WGU), (pt*)(ws + OFF_WD), min(wv_ * (int)gridDim.x + bid, MC_NIT - 1), (int)gridDim.x * 8};
        hy_conv_mfma<1>(lds, Z1, 256, U2 + (size_t)512 * L, 768, RFs + (size_t)256 * RFL, INVN + 256, p.in[17] + (l * 2 + 1) * 256, YT, 256, wv_, mc);
    }
    if constexpr (S == 4) {
        ew_hy_tr(lds, YT, PROJ, NPS, wv_);
        convert_weights(p, l, lds, 2, wv_);
    }
    if constexpr (S == 5) {
        SchedStatic Sc; Sc.init(PROJ, ws + OFF_WO, T, DM, DM, gridDim.x, bid, NPS); pg8::Gemm g{(const pg8::bf16_t*)PROJ, (const pg8::bf16_t*)(ws + OFF_WO), T, DM, DM, NPS};
        EpiBf16Store E{MIXB, DM}; pg8::gemm_phase<EpiBf16Store, SchedStatic, true, true>(lds, g, Sc, E, wv_);
    }
    if constexpr (S == 6) { GS_LOOP(NSLOT) TOKR[id] = 0; }
    if constexpr (S == 6) ew_ln1_route<true, true>(lds, HB, nullptr, MIXB, p.in[19] + l * DM, p.in[20] + l * DM, HB1, p.in[21] + l * DM * 4, p.in[22] + l * 4, p.in[23] + l * DM * 16, p.in[24] + l * 16, RE, RW, CNT, wv_);
    if constexpr (S == 7) ew_assign_gather(lds, RE, CNT, CUR, SLOT, HB1, XS, wv_, TOKR);
    if constexpr (S == 8) { SchedMoE Sc; Sc.init(HB1, ws + OFF_WGU, DM, CNT, (size_t)1024 * 1024 * 2, gridDim.x, bid, TOKR); pg8::Gemm g{(const pg8::bf16_t*)HB1, (const pg8::bf16_t*)(ws + OFF_WGU), NSLOT, 1024, DM, DM};
        EpiSiluMul E{HID}; pg8::gemm_phase<EpiSiluMul, SchedMoE, true, true, true>(lds, g, Sc, E, wv_);
        if (l + 1 < DEPTH) {
            const int G = gridDim.x, nun = Sc.ntiles * 4, rounds = (nun + G - 1) / G, nlast = nun - (rounds - 1) * G, nidle = G - nlast;
            if (nidle >= 64) { if (bid >= nlast) convert_weights(p, l + 1, lds, 1, wv_, bid - nlast, nidle); } else convert_weights(p, l + 1, lds, 1, wv_); } }
    if constexpr (S == 9) { SchedMoE Sc; Sc.init(HID, ws + OFF_WD, 512, CNT, (size_t)1024 * 512 * 2, gridDim.x, bid); pg8::Gemm g{(const pg8::bf16_t*)HID, (const pg8::bf16_t*)(ws + OFF_WD), NSLOT, 1024, 512, 512};
        EpiBf16Store E{Y, DM}; pg8::gemm_phase<EpiBf16Store, SchedMoE, true, true>(lds, g, Sc, E, wv_); }
    if constexpr (S == 10) {
        if (l + 1 < DEPTH) ew_ln2<true>(HB1, nullptr, Y, SLOT, RW, p.in[28] + l * DM, p.in[29] + l * DM, HB, wv_);
        else ew_ln2<true>(HB1, p.out, Y, SLOT, RW, p.in[28] + l * DM, p.in[29] + l * DM, nullptr, wv_);
        __syncthreads();
        if (gtid < 32) CNT[gtid] = 0;
    }
}
#endif
#ifdef CPU_EMU
#define GRID_SYNC()
#define LDSPTR nullptr
#define MEGA_DECL __global__ void mega(MP p, int ph_lo, int ph_hi)
#define MEGA_PRE const int wv_ = 0;
#else
#define GRID_SYNC() xcd_barrier(xbar, wv_)
#define LDSPTR ((void*)lds)
#define MEGA_DECL __global__ void __launch_bounds__(512) mega(MP p, int ph_lo, int ph_hi)
#define MEGA_PRE extern __shared__ __attribute__((aligned(16))) unsigned char lds[]; cg::grid_group grid = cg::this_grid(); if (ph_hi < 0) grid.sync(); \
    const int wv_ = __builtin_amdgcn_readfirstlane((int)(threadIdx.x >> 6)); \
    volatile LAS unsigned* xst = (volatile LAS unsigned*)((LAS unsigned char*)lds + LDS_BYTES - 64); { const int t_ = make_tid(wv_); if (t_ < 4) xst[t_] = 0u; } __syncthreads(); \
    const XcdBarrier xbar = xcd_barrier_post((unsigned*)(p.ws + G_BAR), xst, make_tid(wv_) == 0);
#endif
#define STAGE(SS) do { const int ph_ = 1 + l * NPL + (SS); if (ph_ >= ph_lo && ph_ < ph_hi) { if ((PROBE_MASK >> (SS)) & 1) { run_stage<SS>(p, l, LDSPTR, wv_); GRID_SYNC(); } run_stage<SS>(p, l, LDSPTR, wv_); if (ph_ + 1 < ph_hi) GRID_SYNC(); } } while (0)
MEGA_DECL {
    MEGA_PRE
#ifdef CPU_EMU
    if (ph_lo <= 0 && 0 < ph_hi) { run_stage<-1>(p, 0, LDSPTR, wv_); if (1 < ph_hi) GRID_SYNC(); }
#pragma unroll 1
    for (int l = 0; l < DEPTH; ++l) {
        STAGE(0); STAGE(1); STAGE(2); STAGE(3); STAGE(4); STAGE(5); STAGE(6); STAGE(7); STAGE(8); STAGE(9); STAGE(10); STAGE(11); STAGE(12); STAGE(13); STAGE(14); STAGE(15); STAGE(16); STAGE(17);
    }
#else
#define GSTAGE(SS) do { if ((PROBE_MASK >> (SS)) & 1) { gstage<SS>(p, l, LDSPTR, wv_); GRID_SYNC(); } gstage<SS>(p, l, LDSPTR, wv_); if (!((SS) == NGS - 1 && l == DEPTH - 1)) GRID_SYNC(); } while (0)
    gstage<-1>(p, 0, LDSPTR, wv_); GRID_SYNC();
#pragma unroll 1
    for (int l = 0; l < DEPTH; ++l) {
        GSTAGE(0); GSTAGE(1); GSTAGE(2); GSTAGE(3); GSTAGE(4); GSTAGE(5); GSTAGE(6); GSTAGE(7); GSTAGE(8); GSTAGE(9); GSTAGE(10);
    }
#endif
}

extern "C" void kernel_launch(void* const* d_in, const int* in_sizes, int n_in, void* d_out, int out_size, void* d_ws, size_t ws_size, hipStream_t stream) {
#ifdef CPU_EMU
    if (n_in != 30 || ws_size < WS_NEED || out_size != T * DM) return;
#else
    if (n_in != 30 || ws_size < G_END || out_size != T * DM) return;
#endif
    MP p{};
    for (int i = 0; i < 30; ++i) p.in[i] = (const float*)d_in[i];
    p.out = (float*)d_out; p.ws = (char*)d_ws;
#ifdef CPU_EMU
    for (int ph = 0; ph < NPH; ++ph) { cpu_launch(8, 512, [&] { mega(p, ph, ph + 1); }); }
#else
    static int grid_blocks = 0;
    if (!grid_blocks) {
        int dev = 0, cus = 0, per_cu = 0;
        (void)hipGetDevice(&dev);
        (void)hipDeviceGetAttribute(&cus, hipDeviceAttributeMultiprocessorCount, dev);
        (void)hipFuncSetAttribute((const void*)mega, hipFuncAttributeMaxDynamicSharedMemorySize, LDS_BYTES);
        (void)hipOccupancyMaxActiveBlocksPerMultiprocessor(&per_cu, mega, 512, LDS_BYTES);
        if (per_cu < 1) per_cu = 1;
        grid_blocks = cus * per_cu;
    }
    int lo = 0, hi = NPH;
    void* args[] = {&p, &lo, &hi};
    (void)hipMemsetAsync((char*)d_ws + G_BAR, 0, 3456 * 4, stream);
    hipError_t e = hipLaunchCooperativeKernel((void*)mega, dim3(grid_blocks), dim3(512), args, LDS_BYTES, stream);
    if (e != hipSuccess) fprintf(stderr, "cooperative launch failed: %s (grid %d)\n", hipGetErrorString(e), grid_blocks);
#endif
}
```
